# Optimizing an MI355X kernel written in HIP

```python
import jax, jax.numpy as jnp
from jax import lax
import numpy as np

D_MODEL = 1024
BATCH = 2
SEQ = 8192
DEPTH = 2

EPS = 1e-6
ROPE_BASE = 10000.0
MASK_VALUE = -1e30
LOG_FLOOR = 1e-20

HG_HEADS = 4
HG_DK = 128
HG_DV = 128
HG_WIDTH = HG_HEADS * HG_DV
HG_CHUNK = 64

MLA_HEADS = 8
MLA_D_NOPE = 64
MLA_D_ROPE = 32
MLA_D_V = 64
MLA_D_C = 256
MLA_D_CQ = 768
MLA_WIDTH = MLA_HEADS * MLA_D_V
MLA_Q_BLOCK = 128

RET_HEADS = 4
RET_DK = 64
RET_DV = 128
RET_WIDTH = RET_HEADS * RET_DV
RET_CHUNK = 128

IN_SIZES = (
    HG_HEADS * HG_DK, HG_HEADS * HG_DK, HG_WIDTH, HG_WIDTH,
    MLA_D_CQ, MLA_D_C, MLA_D_ROPE, MLA_WIDTH,
    RET_HEADS * RET_DK, RET_HEADS * RET_DK, RET_WIDTH, RET_WIDTH,
    D_MODEL, D_MODEL, D_MODEL,
)
D_IN = sum(IN_SIZES)

kernel_name = "hybrid_hgrn2_mla_retention_block"


def rmsnorm(x, g=None):
    xf = x.astype(jnp.float32)
    y = xf * lax.rsqrt(jnp.mean(xf * xf, axis=-1, keepdims=True) + EPS)
    if g is not None:
        y = y * g.astype(jnp.float32)
    return y.astype(x.dtype)


def split_cols(p):
    parts, start = [], 0
    for s in IN_SIZES:
        parts.append(p[..., start:start + s])
        start += s
    return parts


def rope_tables(positions, dim):
    inv = ROPE_BASE ** (-jnp.arange(0, dim, 2, dtype=jnp.float32) / dim)
    ang = positions.astype(jnp.float32)[..., None] * inv
    return jnp.cos(ang), jnp.sin(ang)


def apply_rope(x, cos, sin):
    half = x.shape[-1] // 2
    x1, x2 = x[..., :half], x[..., half:]
    return jnp.concatenate([x1 * cos - x2 * sin, x2 * cos + x1 * sin], axis=-1)


def hgrn2_mixer(q_raw, f_raw, i_raw, lb, onorm_g):
    B, T, _ = q_raw.shape
    H, DK, DV, C = HG_HEADS, HG_DK, HG_DV, HG_CHUNK
    N = T // C
    q = jax.nn.silu(q_raw.astype(jnp.float32)) * (DK ** -0.5)
    z = f_raw.astype(jnp.float32)
    lb = lb.astype(jnp.float32)
    f = lb + (1.0 - lb) * jax.nn.sigmoid(z)
    log_f = jnp.log(jnp.maximum(f, LOG_FLOOR))
    k = (1.0 - lb) * jax.nn.sigmoid(-z)
    v = i_raw.astype(jnp.float32)

    def chunks(a, d):
        return a.reshape(B, N, C, H, d).transpose(1, 0, 3, 2, 4)

    causal = jnp.tril(jnp.ones((C, C), dtype=bool))[:, :, None]

    def step(S, inp):
        qc, kc, vc, gc = inp
        b = jnp.cumsum(gc, axis=2)
        diff = b[:, :, :, None, :] - b[:, :, None, :, :]
        decay = jnp.where(causal, jnp.exp(jnp.where(causal, diff, 0.0)), 0.0)
        attn = jnp.einsum('bhtd,bhsd,bhtsd->bhts', qc, kc, decay)
        o = jnp.einsum('bhts,bhsv->bhtv', attn, vc) + jnp.einsum('bhtd,bhdv->bhtv', qc * jnp.exp(b), S)
        b_last = b[:, :, -1:, :]
        S = jnp.exp(b_last[:, :, 0, :])[..., None] * S + jnp.einsum('bhsd,bhsv->bhdv', kc * jnp.exp(b_last - b), vc)
        return S, o

    S0 = jnp.zeros((B, H, DK, DV), jnp.float32)
    _, o = lax.scan(step, S0, (chunks(q, DK), chunks(k, DK), chunks(v, DV), chunks(log_f, DK)))
    o = o.transpose(1, 0, 3, 2, 4).reshape(B, T, H, DV)
    o = rmsnorm(o, onorm_g)
    return o.reshape(B, T, H * DV)


def mla_mixer(c_q, c_kv, k_rope_raw, g_cq, w_uq, g_ckv, w_ukv, cos, sin):
    B, T, _ = c_q.shape
    H, QB = MLA_HEADS, MLA_Q_BLOCK
    f32 = jnp.float32
    q = (rmsnorm(c_q.astype(f32), g_cq) @ w_uq.astype(f32)).reshape(B, T, H, MLA_D_NOPE + MLA_D_ROPE)
    q = q.transpose(0, 2, 1, 3)
    q_nope = q[..., :MLA_D_NOPE]
    q_rope = apply_rope(q[..., MLA_D_NOPE:], cos[:, None], sin[:, None])
    kv = (rmsnorm(c_kv.astype(f32), g_ckv) @ w_ukv.astype(f32)).reshape(B, T, H, MLA_D_NOPE + MLA_D_V)
    kv = kv.transpose(0, 2, 1, 3)
    k_nope, v = kv[..., :MLA_D_NOPE], kv[..., MLA_D_NOPE:]
    k_rope = apply_rope(k_rope_raw.astype(f32), cos, sin)
    scale = (MLA_D_NOPE + MLA_D_ROPE) ** -0.5
    nb = T // QB
    qn_b = q_nope.reshape(B, H, nb, QB, MLA_D_NOPE).transpose(2, 0, 1, 3, 4)
    qr_b = q_rope.reshape(B, H, nb, QB, MLA_D_ROPE).transpose(2, 0, 1, 3, 4)
    key_idx = jnp.arange(T)

    def block(args):
        qn, qr, start = args
        s = (jnp.einsum('bhqd,bhkd->bhqk', qn, k_nope) + jnp.einsum('bhqd,bkd->bhqk', qr, k_rope)) * scale
        q_idx = start + jnp.arange(QB)
        s = jnp.where(key_idx[None, :] <= q_idx[:, None], s, MASK_VALUE)
        p = jax.nn.softmax(s, axis=-1)
        return jnp.einsum('bhqk,bhkv->bhqv', p, v)

    o = lax.map(block, (qn_b, qr_b, jnp.arange(nb, dtype=jnp.int32) * QB))
    return o.transpose(1, 0, 3, 2, 4).reshape(B, T, H * MLA_D_V)


def retention_mixer(q_raw, k_raw, v_raw, cos, sin):
    B, T, _ = q_raw.shape
    H, DK, DV, C = RET_HEADS, RET_DK, RET_DV, RET_CHUNK
    N = T // C
    f32 = jnp.float32
    q = apply_rope(q_raw.astype(f32).reshape(B, T, H, DK).transpose(0, 2, 1, 3), cos[:, None], sin[:, None])
    k = apply_rope(k_raw.astype(f32).reshape(B, T, H, DK).transpose(0, 2, 1, 3), cos[:, None], sin[:, None]) * (DK ** -0.5)
    v = v_raw.astype(f32).reshape(B, T, H, DV).transpose(0, 2, 1, 3)
    log_gamma = jnp.log1p(-jnp.exp2(-5.0 - jnp.arange(H, dtype=f32)))
    qc = q.reshape(B, H, N, C, DK)
    kc = k.reshape(B, H, N, C, DK)
    vc = v.reshape(B, H, N, C, DV)
    pos = jnp.arange(C, dtype=f32)
    rel = pos[:, None] - pos[None, :]
    dmat = jnp.where(rel >= 0, jnp.exp(log_gamma[:, None, None] * jnp.maximum(rel, 0.0)), 0.0)
    scores = jnp.einsum('bhntd,bhnsd->bhnts', qc, kc) * dmat[None, :, None]
    o = jnp.einsum('bhnts,bhnsv->bhntv', scores, vc)
    k_dec = kc * jnp.exp(log_gamma[:, None] * (C - 1 - pos))[None, :, None, :, None]
    U = jnp.einsum('bhnsd,bhnsv->nbhdv', k_dec, vc)
    chunk_decay = jnp.exp(log_gamma * C)[None, :, None, None]

    def step(R, u):
        return chunk_decay * R + u, R

    _, R_prev = lax.scan(step, jnp.zeros((B, H, DK, DV), f32), U)
    q_dec = qc * jnp.exp(log_gamma[:, None] * (pos + 1.0))[None, :, None, :, None]
    o = o + jnp.einsum('bhntd,nbhdv->bhntv', q_dec, R_prev)
    o = o.reshape(B, H, T, DV).transpose(0, 2, 1, 3)
    o = rmsnorm(o)
    return o.reshape(B, T, H * DV)


def setup_inputs(seed: int = 0) -> dict:
    key = jax.random.key(seed)
    ks = jax.random.split(key, 20)
    f32 = jnp.float32

    def nrm(k, shape, fan_in):
        return jax.random.normal(k, shape, f32) * (fan_in ** -0.5)

    def gain(k, shape):
        return 1.0 + 0.01 * jax.random.normal(k, shape, f32)

    return {
        "x": jax.random.normal(ks[0], (BATCH, SEQ, D_MODEL), f32),
        "c": jax.random.normal(ks[1], (BATCH, D_MODEL), f32),
        "positions": jnp.broadcast_to(jnp.arange(SEQ, dtype=jnp.int32), (BATCH, SEQ)),
        "norm_g": gain(ks[2], (DEPTH, D_MODEL)),
        "w_mod": 0.5 * nrm(ks[3], (DEPTH, D_MODEL, 3 * D_MODEL), D_MODEL),
        "b_mod": 0.01 * jax.random.normal(ks[4], (DEPTH, 3 * D_MODEL), f32),
        "w_in": nrm(ks[5], (DEPTH, D_MODEL, D_IN), D_MODEL),
        "hg_lb_logits": 0.5 * jax.random.normal(ks[6], (DEPTH, HG_HEADS * HG_DK), f32),
        "hg_onorm_g": gain(ks[7], (DEPTH, HG_DV)),
        "mla_g_cq": gain(ks[8], (DEPTH, MLA_D_CQ)),
        "mla_w_uq": nrm(ks[9], (DEPTH, MLA_D_CQ, MLA_HEADS * (MLA_D_NOPE + MLA_D_ROPE)), MLA_D_CQ),
        "mla_g_ckv": gain(ks[10], (DEPTH, MLA_D_C)),
        "mla_w_ukv": nrm(ks[11], (DEPTH, MLA_D_C, MLA_HEADS * (MLA_D_NOPE + MLA_D_V)), MLA_D_C),
        "w_pa": nrm(ks[12], (DEPTH, HG_WIDTH, D_MODEL), HG_WIDTH),
        "w_pb": nrm(ks[13], (DEPTH, MLA_WIDTH, D_MODEL), MLA_WIDTH),
        "w_pc": nrm(ks[14], (DEPTH, RET_WIDTH, D_MODEL), RET_WIDTH),
        "w_out": nrm(ks[15], (DEPTH, D_MODEL, D_MODEL), D_MODEL),
        "final_g": gain(ks[16], (D_MODEL,)),
    }


def reference(x, c, positions, norm_g, w_mod, b_mod, w_in, hg_lb_logits, hg_onorm_g,
              mla_g_cq, mla_w_uq, mla_g_ckv, mla_w_ukv, w_pa, w_pb, w_pc, w_out, final_g):
    cos_m, sin_m = rope_tables(positions, MLA_D_ROPE)
    cos_r, sin_r = rope_tables(positions, RET_DK)
    p_lb = jax.nn.softmax(hg_lb_logits.astype(jnp.float32), axis=0)
    lower_bounds = jnp.cumsum(p_lb, axis=0) - p_lb[0:1]
    cond = jax.nn.silu(c)
    for l in range(DEPTH):
        mod = cond @ w_mod[l] + b_mod[l]
        shift = mod[:, None, :D_MODEL]
        scale = mod[:, None, D_MODEL:2 * D_MODEL]
        gate = mod[:, None, 2 * D_MODEL:]
        h = rmsnorm(x, norm_g[l]) * (1.0 + scale) + shift
        (a_q, a_f, a_i, a_g, b_cq, b_ckv, b_kr, b_g,
         c_q, c_k, c_v, c_g, m_a, m_b, m_c) = split_cols(h @ w_in[l])
        y_a = hgrn2_mixer(a_q, a_f, a_i, lower_bounds[l], hg_onorm_g[l]).astype(x.dtype) * jax.nn.silu(a_g)
        y_b = mla_mixer(b_cq, b_ckv, b_kr, mla_g_cq[l], mla_w_uq[l], mla_g_ckv[l], mla_w_ukv[l],
                        cos_m, sin_m).astype(x.dtype) * jax.nn.silu(b_g)
        y_c = retention_mixer(c_q, c_k, c_v, cos_r, sin_r).astype(x.dtype) * jax.nn.silu(c_g)
        merged = (jax.nn.sigmoid(m_a) * (y_a @ w_pa[l])
                  + jax.nn.sigmoid(m_b) * (y_b @ w_pb[l])
                  + jax.nn.sigmoid(m_c) * (y_c @ w_pc[l]))
        x = x + gate * (merged @ w_out[l])
    return rmsnorm(x, final_g)
```

```cpp
#include <hip/hip_runtime.h>
#include <hip/hip_cooperative_groups.h>
#include <cstdio>
#include <cstdint>
namespace cg = cooperative_groups;

#define DI __device__ __forceinline__
typedef unsigned short bf16_t;
typedef short bf16x8 __attribute__((ext_vector_type(8)));
typedef float f32x4 __attribute__((ext_vector_type(4)));
typedef float f32x16 __attribute__((ext_vector_type(16)));
typedef float f32x2 __attribute__((ext_vector_type(2)));
typedef unsigned u32x2 __attribute__((ext_vector_type(2)));
typedef unsigned u32x4 __attribute__((ext_vector_type(4)));
typedef __bf16 bf16x2_t __attribute__((ext_vector_type(2)));

#ifndef ONE_LAUNCH
#define ONE_LAUNCH 1
#endif
#define REP0 1
#define REP1 1
#define REP2 1
#define REP3 1
#define REP4 1
#define REP5 1
#define REPG3 1
#define REPA3 1
#define REPG2 1
#define REPQ2 1
#define REPK2 1

constexpr int SEQ = 8192, NTOK = 16384, DM = 1024;
constexpr int PC = 5152;
constexpr int DIN = 8224;
constexpr int C_HQ = 0, C_HZ = 512, C_HV = 1024, C_HG = 1536, C_CQ = 2048, C_CKV = 2816, C_GB = 3072,
              C_RQ = 3584, C_RK = 3840, C_RV = 4096, C_RG = 4608, C_KR = 5120;
constexpr float EPSF = 1e-6f;
constexpr float LOG2_1E4 = 13.287712379549449f;
constexpr float QSCALE = 0.10206207261596577f * 1.4426950408889634f;

constexpr size_t OFF_MOD = 4096;
constexpr size_t OFF_LB  = OFF_MOD + 2 * 2 * 3072 * 4;
constexpr size_t OFF_SSQ = OFF_LB + 2 * 512 * 4;
constexpr size_t OFF_HGB = OFF_SSQ + 16384 * 2 * 4;
constexpr size_t OFF_HGU = 262144;
constexpr size_t OFF_RTU = OFF_HGU + 128ull * 16384 * 4;
constexpr size_t OFF_WM  = OFF_RTU + 128ull * 8192 * 4;
constexpr size_t OFF_WUQ = OFF_WM + 3072ull * 1024 * 2;
constexpr size_t OFF_WUKV = OFF_WUQ + 768ull * 768 * 2;
constexpr size_t OFF_WP  = OFF_WUKV + 1024ull * 256 * 2;
constexpr size_t OFF_WOUT = OFF_WP + 3ull * 1024 * 512 * 2;
constexpr size_t OFF_H   = OFF_WOUT + 1024ull * 1024 * 2;
constexpr size_t OFF_P   = OFF_H + 16384ull * 1024 * 2;
constexpr size_t OFF_KN  = OFF_P + 16384ull * PC * 2;
constexpr size_t OFF_VT  = OFF_KN + 16384ull * 512 * 2;
constexpr size_t OFF_WKR = OFF_VT + 16384ull * 512 * 2;
constexpr size_t OFF_BAR = OFF_WKR + 32ull * 1024 * 2;
constexpr size_t BAR_BYTES = 8192;
constexpr size_t WS_END  = OFF_BAR + BAR_BYTES;
static_assert(OFF_HGB + 128 * 128 * 4 <= OFF_HGU, "ws map");
static_assert(WS_END <= 268435456ull, "workspace too large");
static_assert(OFF_P % 256 == 0 && OFF_KN % 256 == 0 && OFF_H % 256 == 0, "align");

struct Params {
    const float* x; const float* c; const int* pos; const float* norm_g; const float* w_mod; const float* b_mod; const float* w_in;
    const float* hg_lb; const float* hg_onorm; const float* g_cq; const float* w_uq; const float* g_ckv; const float* w_ukv;
    const float* w_pa; const float* w_pb; const float* w_pc; const float* w_out; const float* final_g;
    float* out; unsigned char* ws;
};


DI float bf2f(bf16_t v) { return __uint_as_float(((unsigned)v) << 16); }
DI unsigned pk2(float lo, float hi) { f32x2 v = {lo, hi}; bf16x2_t b = __builtin_convertvector(v, bf16x2_t); return __builtin_bit_cast(unsigned, b); }
DI bf16_t f2bf(float v) { return (bf16_t)(pk2(v, 0.f) & 0xffffu); }
DI u32x2 pk4(f32x4 v) { u32x2 r; r.x = pk2(v[0], v[1]); r.y = pk2(v[2], v[3]); return r; }
DI f32x4 unpk4(u32x2 u) { f32x4 r; r[0] = __uint_as_float(u.x << 16); r[1] = __uint_as_float(u.x & 0xffff0000u); r[2] = __uint_as_float(u.y << 16); r[3] = __uint_as_float(u.y & 0xffff0000u); return r; }
DI float sigmoidf_(float v) { return __builtin_amdgcn_rcpf(1.f + __builtin_amdgcn_exp2f(-1.4426950408889634f * v)); }
DI float siluf_(float v) { return v * __builtin_amdgcn_rcpf(1.f + __builtin_amdgcn_exp2f(-1.4426950408889634f * v)); }
DI int tid8_() { int t = threadIdx.x; asm volatile("" : "+v"(t)); return t; }
DI int tid_() { return tid8_() & 255; }
DI int vb_() { return __builtin_amdgcn_readfirstlane(tid8_() >> 8); }
DI int grab_item(unsigned* ctr, unsigned char* sm) {
    __syncthreads();
    if (tid8_() == 0) *(volatile int*)sm = (int)atomicAdd(ctr, 1u);
    __syncthreads();
    const int it = *(volatile int*)sm;
    __syncthreads();
    return it;
}
#define GB_GRP(g)  (64u * (1u + (g)))
#define GB_GGEN(g) (64u * (9u + (g)))
#define GB_TOP     (64u * 17u)
#define GB_TOPGEN  (64u * 18u)
DI unsigned gb_ld(unsigned* p) { return __hip_atomic_load(p, __ATOMIC_RELAXED, __HIP_MEMORY_SCOPE_AGENT); }
DI unsigned gb_add(unsigned* p) { return __hip_atomic_fetch_add(p, 1u, __ATOMIC_RELAXED, __HIP_MEMORY_SCOPE_AGENT); }
DI void grid_barrier(unsigned* bar, unsigned k) {
    asm volatile("s_waitcnt vmcnt(0)" ::: "memory");
    __syncthreads();
    if (tid8_() == 0) {
        const unsigned g = blockIdx.x & 7u, nloc = gridDim.x >> 3;
        __builtin_amdgcn_fence(__ATOMIC_RELEASE, "agent");
        asm volatile("s_waitcnt vmcnt(0)" ::: "memory");
        const unsigned old = gb_add(&bar[GB_GRP(g)]);
        if (old + 1u == k * nloc) {
            const unsigned og = gb_add(&bar[GB_TOP]);
            if (og + 1u == k * 8u) gb_add(&bar[GB_TOPGEN]);
            else while (gb_ld(&bar[GB_TOPGEN]) < k) __builtin_amdgcn_s_sleep(1);
            gb_add(&bar[GB_GGEN(g)]);
        } else {
            while (gb_ld(&bar[GB_GGEN(g)]) < k) __builtin_amdgcn_s_sleep(2);
        }
        __builtin_amdgcn_fence(__ATOMIC_ACQUIRE, "agent");
        asm volatile("s_waitcnt vmcnt(0)" ::: "memory");
    }
    __syncthreads();
}
DI int crow(int i, int hh) { return (i & 3) + 8 * (i >> 2) + 4 * hh; }
DI f32x16 mfma32(bf16x8 a, bf16x8 b, f32x16 c) { return __builtin_amdgcn_mfma_f32_32x32x16_bf16(a, b, c, 0, 0, 0); }
DI f32x4 mfma16(bf16x8 a, bf16x8 b, f32x4 c) { return __builtin_amdgcn_mfma_f32_16x16x32_bf16(a, b, c, 0, 0, 0); }
DI bf16x8 pack8(float a0, float a1, float a2, float a3, float a4, float a5, float a6, float a7) {
    u32x4 u; u.x = pk2(a0, a1); u.y = pk2(a2, a3); u.z = pk2(a4, a5); u.w = pk2(a6, a7); return __builtin_bit_cast(bf16x8, u);
}
DI bf16x8 join8(u32x2 lo, u32x2 hi) { u32x4 u; u.x = lo.x; u.y = lo.y; u.z = hi.x; u.w = hi.y; return __builtin_bit_cast(bf16x8, u); }
DI float warp_sum(float v) {
#pragma unroll
    for (int o = 32; o > 0; o >>= 1) v += __shfl_xor(v, o);
    return v;
}
DI void rope2(float& a, float& b, float ang) {
    const float n = rintf(ang * 0.15915493667125702f);
    float r = __builtin_fmaf(ang, 0.15915493667125702f, -n);
    r = __builtin_fmaf(ang, 6.4206382432985265e-09f, r);
    const float s = __builtin_amdgcn_sinf(r), c = __builtin_amdgcn_cosf(r);
    const float x1 = a, x2 = b; a = x1 * c - x2 * s; b = x2 * c + x1 * s;
}

template <bool FRAG = false>
DI void conv_tile(const float* __restrict__ src, int ldsrc, int srccol0, int k0, bf16_t* dst, int lddst, int n0,
                  const float* __restrict__ rowscale, float sc, float* sm) {
    const int tid = tid_(), nn = tid & 31, kk0 = tid >> 5;
#pragma unroll 4
    for (int i = 0; i < 16; ++i) {
        const int kk = kk0 + 8 * i;
        float v = src[(size_t)(k0 + kk) * ldsrc + srccol0 + nn];
        if (rowscale) v *= rowscale[k0 + kk];
        sm[kk * 33 + nn] = v * sc;
    }
    __syncthreads();
    const int kp = 2 * (tid & 63), nb = tid >> 6;
#pragma unroll
    for (int i = 0; i < 8; ++i) {
        const int n = nb + 4 * i;
        const int ng = n0 + n, kg = k0 + kp;
        const size_t off = FRAG ? ((size_t)((ng >> 4) * (lddst >> 5) + (kg >> 5)) * 512 + (((ng & 15) + 16 * ((kg >> 3) & 3)) << 3) + (kg & 7)) : ((size_t)ng * lddst + kg);
        *(unsigned*)(dst + off) = pk2(sm[kp * 33 + n], sm[(kp + 1) * 33 + n]);
    }
    __syncthreads();
}

constexpr int CONV_ITEMS = 1288 + 768 + 144 + 64 + 384 + 256;
DI void conv_weights(const Params& p, int l, int item, float* sm) {
    unsigned char* ws = p.ws;
    const float* w_in = p.w_in + (size_t)l * 1024 * DIN;
    if (item < 1288) { const int n0 = (item >> 3) * 32, kb = item & 7; const int sc0 = n0 < 3072 ? n0 : (n0 < 5120 ? n0 + 32 : 3072);
        if (n0 >= 5120) conv_tile(w_in, DIN, sc0, kb * 128, (bf16_t*)(ws + OFF_WKR), 1024, n0 - 5120, nullptr, 1.f, sm);
        else conv_tile(w_in, DIN, sc0, kb * 128, (bf16_t*)(ws + OFF_KN), 1024, n0, nullptr, 1.f, sm);
        return; }
    item -= 1288;
    if (item < 768) { const int n0 = (item >> 3) * 32, kb = item & 7;
        conv_tile(w_in, DIN, 5152 + n0, kb * 128, (bf16_t*)(ws + OFF_WM), 1024, n0, nullptr, 1.f, sm); return; }
    item -= 768;
    if (item < 144) { const int n0 = (item / 6) * 32, kb = item % 6; const int sc0 = n0 < 512 ? (n0 >> 6) * 96 + (n0 & 63) : ((n0 - 512) >> 5) * 96 + 64;
        conv_tile<true>(p.w_uq + (size_t)l * 768 * 768, 768, sc0, kb * 128, (bf16_t*)(ws + OFF_WUQ), 768, n0, p.g_cq + l * 768, QSCALE, sm); return; }
    item -= 144;
    if (item < 64) { const int n0 = (item >> 1) * 32, kb = item & 1;
        conv_tile(p.w_ukv + (size_t)l * 256 * 1024, 1024, n0, kb * 128, (bf16_t*)(ws + OFF_WUKV), 256, n0, p.g_ckv + l * 256, 1.f, sm); return; }
    item -= 64;
    if (item < 384) { const int br = item >> 7, r = item & 127, n0 = (r >> 2) * 32, kb = r & 3;
        const float* w = (br == 0 ? p.w_pa : (br == 1 ? p.w_pb : p.w_pc)) + (size_t)l * 512 * 1024;
        conv_tile(w, 1024, n0, kb * 128, (bf16_t*)(ws + OFF_WP) + (size_t)br * 1024 * 512, 512, n0, nullptr, 1.f, sm); return; }
    item -= 384;
    { const int n0 = (item >> 3) * 32, kb = item & 7;
        conv_tile(p.w_out + (size_t)l * 1024 * 1024, 1024, n0, kb * 128, (bf16_t*)(ws + OFF_WOUT), 1024, n0, nullptr, 1.f, sm); }
}

DI void mod_item(const Params& p, int item, float* sm) {
    const int l = item / 96, n0 = (item % 96) * 32, tid = tid_(), nn = tid & 31, ks = tid >> 5;
    float* sc = sm + 1024;
    for (int e = tid; e < 2048; e += 256) sc[e] = siluf_(p.c[e]);
    __syncthreads();
    const float* w = p.w_mod + (size_t)l * 1024 * 3072 + n0 + nn + (size_t)(ks * 128) * 3072;
    float s0 = 0.f, s1 = 0.f;
#pragma unroll 1
    for (int k0 = 0; k0 < 128; k0 += 16) {
        float wv[16];
#pragma unroll
        for (int u = 0; u < 16; ++u) wv[u] = w[(size_t)(k0 + u) * 3072];
#pragma unroll
        for (int u = 0; u < 16; ++u) { s0 += sc[ks * 128 + k0 + u] * wv[u]; s1 += sc[1024 + ks * 128 + k0 + u] * wv[u]; }
    }
    sm[(ks * 32 + nn) * 2] = s0; sm[(ks * 32 + nn) * 2 + 1] = s1;
    __syncthreads();
    if (tid < 64) { const int n = tid & 31, b = tid >> 5; float s = 0.f;
        for (int q = 0; q < 8; ++q) s += sm[(q * 32 + n) * 2 + b];
        ((float*)(p.ws + OFF_MOD))[(l * 2 + b) * 3072 + n0 + n] = s + p.b_mod[l * 3072 + n0 + n]; }
    __syncthreads();
}
DI void lb_item(const Params& p) {
    float* LB = (float*)(p.ws + OFF_LB);
    for (int ch = tid_(); ch < 512; ch += 256) {
        const float l0 = p.hg_lb[ch], l1 = p.hg_lb[512 + ch];
        LB[ch] = 0.f; LB[512 + ch] = 1.f / (1.f + expf(l0 - l1));
    }
}

DI void norm_item(const Params& p, int l, int item) {
    const int tid__ = tid_(), lane = tid__ & 63, row = item * 4 + (tid__ >> 6), b = row >> 13;
    const float* xin = (l == 0 ? p.x : p.out) + (size_t)row * 1024;
    f32x4 v[4]; float ss = 0.f;
#pragma unroll
    for (int i = 0; i < 4; ++i) { v[i] = *(const f32x4*)(xin + lane * 4 + 256 * i); ss += v[i][0] * v[i][0] + v[i][1] * v[i][1] + v[i][2] * v[i][2] + v[i][3] * v[i][3]; }
    ss = warp_sum(ss);
    const float rstd = rsqrtf(ss * (1.f / 1024.f) + EPSF);
    const float* mod = (const float*)(p.ws + OFF_MOD) + (l * 2 + b) * 3072;
    bf16_t* h = (bf16_t*)(p.ws + OFF_H) + (size_t)row * 1024;
#pragma unroll
    for (int i = 0; i < 4; ++i) {
        const int col = lane * 4 + 256 * i;
        const f32x4 g = *(const f32x4*)(p.norm_g + l * 1024 + col), sh = *(const f32x4*)(mod + col), sc = *(const f32x4*)(mod + 1024 + col);
        f32x4 o;
#pragma unroll
        for (int j = 0; j < 4; ++j) o[j] = v[i][j] * rstd * g[j] * (1.f + sc[j]) + sh[j];
        *(u32x2*)(h + col) = pk4(o);
    }
    if (lane == 0) { float* ssq = (float*)(p.ws + OFF_SSQ) + row * 2; ssq[0] = 0.f; ssq[1] = 0.f; }
}
DI void final_item(const Params& p, int item) {
    const int tid__ = tid_(), lane = tid__ & 63, row = item * 4 + (tid__ >> 6);
    float* xr = p.out + (size_t)row * 1024;
    f32x4 v[4]; float ss = 0.f;
#pragma unroll
    for (int i = 0; i < 4; ++i) { v[i] = *(const f32x4*)(xr + lane * 4 + 256 * i); ss += v[i][0] * v[i][0] + v[i][1] * v[i][1] + v[i][2] * v[i][2] + v[i][3] * v[i][3]; }
    ss = warp_sum(ss);
    const float rstd = rsqrtf(ss * (1.f / 1024.f) + EPSF);
#pragma unroll
    for (int i = 0; i < 4; ++i) {
        const int col = lane * 4 + 256 * i; const f32x4 g = *(const f32x4*)(p.final_g + col);
        f32x4 o;
#pragma unroll
        for (int j = 0; j < 4; ++j) o[j] = v[i][j] * rstd * g[j];
        *(f32x4*)(xr + col) = o;
    }
}

template <int MT, int NT, int WN>
DI void gemm8(const bf16_t* A, int lda, const bf16_t* Bt, int ldb, int K, f32x4 (&acc)[MT][NT], unsigned char* smb) {
    constexpr int WM = 8 / WN, BM = 16 * MT * WM, BN = 16 * NT * WN;
    static_assert(BM == 256, "block tile is 256 rows");
    constexpr int A_B = BM * 128, B_B = BN * 128, ST_B = A_B + B_B, NA = BM / 64, NB = BN / 64;
    const int tid = tid8_(), lane = tid & 63, wave = tid >> 6, wm = wave / WN, wn = wave % WN;
    const int fr = lane & 15, fq = lane >> 4, lr = lane >> 3, pc = lane & 7;
    const bf16_t* ag[NA]; const bf16_t* bg[NB];
#pragma unroll
    for (int i = 0; i < NA; ++i) { const int row = 8 * (8 * i + wave) + lr, c = pc ^ ((row >> 1) & 7); ag[i] = A + (size_t)row * lda + c * 8; }
#pragma unroll
    for (int i = 0; i < NB; ++i) { const int row = 8 * (8 * i + wave) + lr, c = pc ^ ((row >> 1) & 7); bg[i] = Bt + (size_t)row * ldb + c * 8; }
    auto stage = [&](int buf, int ko) {
#pragma unroll
        for (int i = 0; i < NA; ++i) __builtin_amdgcn_global_load_lds((const unsigned*)(ag[i] + ko), (unsigned*)(smb + buf * ST_B + (8 * i + wave) * 1024), 16, 0, 0);
#pragma unroll
        for (int i = 0; i < NB; ++i) __builtin_amdgcn_global_load_lds((const unsigned*)(bg[i] + ko), (unsigned*)(smb + buf * ST_B + A_B + (8 * i + wave) * 1024), 16, 0, 0);
    };
    const int KT = K >> 6;
    const int swz = fr >> 1;
    const int aoff = (16 * MT * wm + fr) * 128, boff = A_B + (16 * NT * wn + fr) * 128;
    stage(0, 0);
    asm volatile("s_waitcnt vmcnt(0)" ::: "memory");
    __syncthreads();
#pragma unroll 1
    for (int kt = 0; kt < KT; ++kt) {
        const int cur = kt & 1;
        if (kt + 1 < KT) stage(cur ^ 1, (kt + 1) * 64);
        const unsigned char* sb = smb + cur * ST_B;
#pragma unroll
        for (int ks = 0; ks < 2; ++ks) {
            const int co = ((4 * ks + fq) ^ swz) << 4;
            bf16x8 af[MT], bf[NT];
#pragma unroll
            for (int i = 0; i < MT; ++i) af[i] = *(const bf16x8*)(sb + aoff + i * 2048 + co);
#pragma unroll
            for (int j = 0; j < NT; ++j) bf[j] = *(const bf16x8*)(sb + boff + j * 2048 + co);
#pragma unroll
            for (int i = 0; i < MT; ++i)
#pragma unroll
                for (int j = 0; j < NT; ++j) acc[i][j] = mfma16(bf[j], af[i], acc[i][j]);
        }
        asm volatile("s_waitcnt vmcnt(0)" ::: "memory");
        __syncthreads();
    }
}
template <int MT, int NT> DI void zero_acc(f32x4 (&acc)[MT][NT]) {
#pragma unroll
    for (int i = 0; i < MT; ++i)
#pragma unroll
        for (int j = 0; j < NT; ++j) acc[i][j] = (f32x4){0.f, 0.f, 0.f, 0.f};
}

constexpr int INPROJ_NT = 20;
DI void inproj_item(const Params& p, int mt, int nt, unsigned char* smb, int dry) {
    const int m0 = mt * 256, n0 = nt * 256;
    f32x4 acc[8][4]; zero_acc<8, 4>(acc);
    gemm8<8, 4, 4>((const bf16_t*)(p.ws + OFF_H) + (size_t)m0 * 1024, 1024, (const bf16_t*)(p.ws + OFF_KN) + (size_t)n0 * 1024, 1024, 1024, acc, smb);
    const int tid = tid8_(), lane = tid & 63, wave = tid >> 6, wm = wave >> 2, wn = wave & 3, fr = lane & 15, fq = lane >> 4;
    const int cb = n0 + 64 * wn;
    bf16_t* P = (bf16_t*)(p.ws + OFF_P);
    const int rbase = m0 + 128 * wm + fr;
    if (cb >= C_RQ && cb < C_RV) {
        const float sc = cb >= C_RK ? 0.125f : 1.f;
#pragma unroll
        for (int i = 0; i < 8; ++i) {
            const int row = rbase + 16 * i; const float pos = (float)p.pos[row];
#pragma unroll
            for (int j = 0; j < 2; ++j)
#pragma unroll
                for (int jj = 0; jj < 4; ++jj) {
                    const int d = 16 * j + 4 * fq + jj; const float inv = exp2f(-(float)d * (LOG2_1E4 / 32.f));
                    float a = acc[i][j][jj], b = acc[i][j + 2][jj]; rope2(a, b, pos * inv); acc[i][j][jj] = a * sc; acc[i][j + 2][jj] = b * sc;
                }
#pragma unroll
            for (int j = 0; j < 4; ++j) *(u32x2*)(P + (size_t)row * PC + cb + 16 * j + 4 * fq) = pk4(acc[i][j]);
        }
    } else {
        const bool is_silu = (cb >= C_HG && cb < C_CQ) || (cb >= C_GB && cb < C_RQ) || (cb >= C_RG && cb < C_KR);
        const bool is_hq = cb < C_HZ;
        const bool is_cq = cb >= C_CQ && cb < C_CKV, is_ckv = cb >= C_CKV && cb < C_GB;
#pragma unroll
        for (int i = 0; i < 8; ++i) {
            const int row = rbase + 16 * i;
            if (is_cq || is_ckv) {
                float s = 0.f;
#pragma unroll
                for (int j = 0; j < 4; ++j) s += acc[i][j][0] * acc[i][j][0] + acc[i][j][1] * acc[i][j][1] + acc[i][j][2] * acc[i][j][2] + acc[i][j][3] * acc[i][j][3];
                s += __shfl_xor(s, 16); s += __shfl_xor(s, 32);
                if (fq == 0 && !dry) atomicAdd((float*)(p.ws + OFF_SSQ) + row * 2 + (is_ckv ? 1 : 0), s);
            }
#pragma unroll
            for (int j = 0; j < 4; ++j) {
                f32x4 v = acc[i][j];
                if (is_silu) {
#pragma unroll
                    for (int jj = 0; jj < 4; ++jj) v[jj] = siluf_(v[jj]);
                } else if (is_hq) {
#pragma unroll
                    for (int jj = 0; jj < 4; ++jj) v[jj] = siluf_(v[jj]) * 0.08838834764831845f;
                }
                *(u32x2*)(P + (size_t)row * PC + cb + 16 * j + 4 * fq) = pk4(v);
            }
        }
    }
}

DI void kr_item(const Params& p, int item) {
    const int tid = tid8_(), lane = tid & 63, wave = tid >> 6, fr = lane & 15, fq = lane >> 4;
    const int r0 = item * 256 + 32 * wave;
    const bf16_t* ap = (const bf16_t*)(p.ws + OFF_H) + (size_t)(r0 + fr) * 1024 + 8 * fq;
    const bf16_t* bp = (const bf16_t*)(p.ws + OFF_WKR) + (size_t)fr * 1024 + 8 * fq;
    f32x4 acc[2][2];
#pragma unroll
    for (int i = 0; i < 2; ++i)
#pragma unroll
        for (int j = 0; j < 2; ++j) acc[i][j] = (f32x4){0.f, 0.f, 0.f, 0.f};
#pragma unroll 4
    for (int ks = 0; ks < 32; ++ks) {
        const bf16x8 a0 = *(const bf16x8*)(ap + 32 * ks), a1 = *(const bf16x8*)(ap + 16 * 1024 + 32 * ks);
        const bf16x8 b0 = *(const bf16x8*)(bp + 32 * ks), b1 = *(const bf16x8*)(bp + 16 * 1024 + 32 * ks);
        acc[0][0] = mfma16(b0, a0, acc[0][0]); acc[0][1] = mfma16(b1, a0, acc[0][1]);
        acc[1][0] = mfma16(b0, a1, acc[1][0]); acc[1][1] = mfma16(b1, a1, acc[1][1]);
    }
    bf16_t* P = (bf16_t*)(p.ws + OFF_P);
#pragma unroll
    for (int i = 0; i < 2; ++i) {
        const int row = r0 + 16 * i + fr; const float pos = (float)p.pos[row];
#pragma unroll
        for (int jj = 0; jj < 4; ++jj) {
            const int d = 4 * fq + jj; const float inv = exp2f(-(float)d * (LOG2_1E4 / 16.f));
            float a = acc[i][0][jj], b = acc[i][1][jj]; rope2(a, b, pos * inv); acc[i][0][jj] = a; acc[i][1][jj] = b;
        }
#pragma unroll
        for (int j = 0; j < 2; ++j) *(u32x2*)(P + (size_t)row * PC + C_KR + 16 * j + 4 * fq) = pk4(acc[i][j]);
    }
}

DI void kvup_item(const Params& p, int mt, int nt, unsigned char* smb) {
    const int m0 = mt * 256, n0 = nt * 256;
    f32x4 acc[8][4]; zero_acc<8, 4>(acc);
    gemm8<8, 4, 4>((const bf16_t*)(p.ws + OFF_P) + (size_t)m0 * PC + C_CKV, PC, (const bf16_t*)(p.ws + OFF_WUKV) + (size_t)n0 * 256, 256, 256, acc, smb);
    const int tid = tid8_(), lane = tid & 63, wave = tid >> 6, wm = wave >> 2, wn = wave & 3, fr = lane & 15, fq = lane >> 4;
    const int cs = n0 + 64 * wn, head = cs >> 7, isv = (cs >> 6) & 1;
    bf16_t* KN = (bf16_t*)(p.ws + OFF_KN); bf16_t* VT = (bf16_t*)(p.ws + OFF_VT);
    const float* ssq = (const float*)(p.ws + OFF_SSQ);
#pragma unroll
    for (int i = 0; i < 8; ++i) {
        const int row = m0 + 128 * wm + 16 * i + fr;
        const float rstd = rsqrtf(ssq[row * 2 + 1] * (1.f / 256.f) + EPSF);
#pragma unroll
        for (int j = 0; j < 4; ++j) {
            f32x4 v = acc[i][j] * rstd; const int w = 16 * j + 4 * fq;
            if (!isv) *(u32x2*)(KN + (size_t)row * 512 + head * 64 + w) = pk4(v);
            else { const int b = row >> 13, t = row & 8191;
#pragma unroll
                for (int jj = 0; jj < 4; ++jj) VT[((size_t)((b * 8 + head) * 64 + w + jj)) * SEQ + t] = f2bf(v[jj]); }
        }
    }
}

DI void qup_item(const Params& p, int item, bf16_t* sm, int dry) {
    const int m0 = item * 64, tid = tid8_(), lane = tid & 63, wave = tid >> 6, fr = lane & 15, fq = lane >> 4;
    bf16_t* P = (bf16_t*)(p.ws + OFF_P);
    constexpr int AP = 776;
#pragma unroll
    for (int i = 0; i < 12; ++i) { const int c = tid + 512 * i, r = c / 96, cc = c % 96;
        *(u32x4*)(sm + r * AP + cc * 8) = *(const u32x4*)(P + (size_t)(m0 + r) * PC + C_CQ + cc * 8); }
    __syncthreads();
    const bf16_t* W = (const bf16_t*)(p.ws + OFF_WUQ);
    const int nc0 = 96 * wave;
    f32x4 acc[4][6];
#pragma unroll
    for (int i = 0; i < 4; ++i)
#pragma unroll
        for (int j = 0; j < 6; ++j) acc[i][j] = (f32x4){0.f, 0.f, 0.f, 0.f};
    const bf16_t* wp = W + (size_t)(nc0 >> 4) * 24 * 512 + lane * 8;
    bf16x8 bq[3][6];
#pragma unroll
    for (int u = 0; u < 3; ++u)
#pragma unroll
        for (int j = 0; j < 6; ++j) bq[u][j] = *(const bf16x8*)(wp + (size_t)(j * 24 + u) * 512);
#pragma unroll 1
    for (int ks0 = 0; ks0 < 24; ks0 += 3) {
#pragma unroll
        for (int u = 0; u < 3; ++u) {
            const int ks = ks0 + u;
            bf16x8 af[4];
#pragma unroll
            for (int i = 0; i < 4; ++i) af[i] = *(const bf16x8*)(sm + (16 * i + fr) * AP + 32 * ks + 8 * fq);
#pragma unroll
            for (int j = 0; j < 6; ++j) {
#pragma unroll
                for (int i = 0; i < 4; ++i) acc[i][j] = mfma16(bq[u][j], af[i], acc[i][j]);
            }
            if (ks + 3 < 24) {
#pragma unroll
                for (int j = 0; j < 6; ++j) bq[u][j] = *(const bf16x8*)(wp + (size_t)(j * 24 + ks + 3) * 512);
            }
        }
    }
    const float* ssq = (const float*)(p.ws + OFF_SSQ);
#pragma unroll
    for (int i = 0; i < 4; ++i) {
        const int row = m0 + 16 * i + fr; const float rstd = rsqrtf(ssq[row * 2] * (1.f / 768.f) + EPSF); const float pos = (float)p.pos[row];
#pragma unroll
        for (int j = 0; j < 6; j += 2) {
            f32x4 a = acc[i][j] * rstd, b = acc[i][j + 1] * rstd; const int col = nc0 + 16 * j;
            if (col >= 512) {
#pragma unroll
                for (int jj = 0; jj < 4; ++jj) { const int d = 4 * fq + jj; const float inv = exp2f(-(float)d * (LOG2_1E4 / 16.f)); float x1 = a[jj], x2 = b[jj]; rope2(x1, x2, pos * inv); a[jj] = x1; b[jj] = x2; }
            }
            if (!dry) { *(u32x2*)(P + (size_t)row * PC + C_CQ + col + 4 * fq) = pk4(a);
            *(u32x2*)(P + (size_t)row * PC + C_CQ + col + 16 + 4 * fq) = pk4(b); }
        }
    }
    __syncthreads();
}

DI void attn_item(const Params& p, int qt, int bh, bf16_t* sm, int dry) {
    const int b = bh >> 3, h = bh & 7;
    const int tid = tid8_(), lane = tid & 63, wave = tid >> 6, ql = lane & 31, hh = lane >> 5;
    const int q0 = qt * 256, tokbase = b * SEQ;
    bf16_t* P = (bf16_t*)(p.ws + OFF_P);
    const bf16_t* KN = (const bf16_t*)(p.ws + OFF_KN); const bf16_t* VT = (const bf16_t*)(p.ws + OFF_VT) + (size_t)((b * 8 + h) * 64) * SEQ;
    const int qrow = tokbase + q0 + 32 * wave + ql;
    bf16x8 qf[6];
    { const bf16_t* qp = P + (size_t)qrow * PC + C_CQ;
#pragma unroll
      for (int ks = 0; ks < 4; ++ks) qf[ks] = *(const bf16x8*)(qp + h * 64 + 16 * ks + 8 * hh);
#pragma unroll
      for (int ks = 0; ks < 2; ++ks) qf[4 + ks] = *(const bf16x8*)(qp + 512 + h * 32 + 16 * ks + 8 * hh); }
    constexpr int KP = 104, VP = 136, KSZ = 128 * KP, VSZ = 64 * VP;
    bf16_t* Ks = sm; bf16_t* Vs = sm + 2 * KSZ;
    f32x16 o[2];
#pragma unroll
    for (int i = 0; i < 16; ++i) { o[0][i] = 0.f; o[1][i] = 0.f; }
    float mrun = 0.f, lsum = 0.f;
    const int nkt = 2 * qt + 2;
    const int qg = q0 + 32 * wave + ql;
    u32x4 rk[3], rv[2];
    auto gload = [&](int kt) {
        const int k0 = tokbase + kt * 128;
#pragma unroll
        for (int i = 0; i < 3; ++i) {
            const int c = tid + 512 * i, key = c / 12, cc = c % 12, tok = k0 + key;
            rk[i] = *(const u32x4*)(cc < 8 ? KN + (size_t)tok * 512 + h * 64 + cc * 8 : P + (size_t)tok * PC + C_KR + (cc - 8) * 8);
        }
#pragma unroll
        for (int i = 0; i < 2; ++i) { const int c = tid + 512 * i; rv[i] = *(const u32x4*)(VT + (size_t)(c >> 4) * SEQ + kt * 128 + (c & 15) * 8); }
    };
    gload(0);
#pragma unroll 1
    for (int kt = 0; kt < nkt; ++kt) {
        const int buf = kt & 1;
        bf16_t* Kb = Ks + buf * KSZ; bf16_t* Vb = Vs + buf * VSZ;
#pragma unroll
        for (int i = 0; i < 3; ++i) { const int c = tid + 512 * i; *(u32x4*)(Kb + (c / 12) * KP + (c % 12) * 8) = rk[i]; }
#pragma unroll
        for (int i = 0; i < 2; ++i) { const int c = tid + 512 * i; *(u32x4*)(Vb + (c >> 4) * VP + (c & 15) * 8) = rv[i]; }
        __syncthreads();
        if (kt + 1 < nkt) gload(kt + 1);
        f32x16 s[4];
        __builtin_amdgcn_s_setprio(1);
        {
#pragma unroll
            for (int sub = 0; sub < 4; ++sub)
#pragma unroll
                for (int i = 0; i < 16; ++i) s[sub][i] = -mrun;
#pragma unroll
            for (int sub = 0; sub < 4; ++sub)
#pragma unroll
                for (int ks = 0; ks < 6; ++ks) {
                    const bf16x8 kf = *(const bf16x8*)(Kb + (32 * sub + ql) * KP + 16 * ks + 8 * hh);
                    s[sub] = mfma32(kf, qf[ks], s[sub]);
                }
            __builtin_amdgcn_sched_group_barrier(0x100, 8, 0);
#pragma unroll
            for (int u = 0; u < 16; ++u) { __builtin_amdgcn_sched_group_barrier(0x008, 1, 0); __builtin_amdgcn_sched_group_barrier(0x100, 1, 0); }
            __builtin_amdgcn_sched_group_barrier(0x008, 8, 0);
        }
        __builtin_amdgcn_s_setprio(0);
        if (kt >= nkt - 2) {
#pragma unroll
            for (int sub = 0; sub < 4; ++sub)
#pragma unroll
                for (int i = 0; i < 16; ++i) { const int kg = kt * 128 + 32 * sub + crow(i, hh); if (kg > qg) s[sub][i] = -1e30f; }
        }
        float mx = s[0][0];
#pragma unroll
        for (int sub = 0; sub < 4; ++sub)
#pragma unroll
            for (int i = 0; i < 16; ++i) mx = fmaxf(mx, s[sub][i]);
        mx = fmaxf(mx, __shfl_xor(mx, 32));
        if (__builtin_amdgcn_ballot_w64(mx > 0.f) != 0) {
            const float delta = fmaxf(mx, 0.f), alpha = __builtin_amdgcn_exp2f(-delta);
            mrun += delta; lsum *= alpha;
#pragma unroll
            for (int i = 0; i < 16; ++i) { s[0][i] -= delta; s[1][i] -= delta; s[2][i] -= delta; s[3][i] -= delta; o[0][i] *= alpha; o[1][i] *= alpha; }
        }
        f32x2 rs2 = {0.f, 0.f};
#pragma unroll
        for (int sub = 0; sub < 4; ++sub)
#pragma unroll
            for (int i = 0; i < 16; i += 2) {
                s[sub][i] = __builtin_amdgcn_exp2f(s[sub][i]); s[sub][i + 1] = __builtin_amdgcn_exp2f(s[sub][i + 1]);
                rs2 += (f32x2){s[sub][i], s[sub][i + 1]};
            }
        lsum += rs2[0] + rs2[1];
#pragma unroll
        for (int sub = 0; sub < 4; ++sub)
#pragma unroll
            for (int s2 = 0; s2 < 2; ++s2) {
                const bf16x8 pf = pack8(s[sub][8 * s2], s[sub][8 * s2 + 1], s[sub][8 * s2 + 2], s[sub][8 * s2 + 3], s[sub][8 * s2 + 4], s[sub][8 * s2 + 5], s[sub][8 * s2 + 6], s[sub][8 * s2 + 7]);
#pragma unroll
                for (int dt = 0; dt < 2; ++dt) {
                    const bf16_t* vp = Vb + (32 * dt + ql) * VP + 32 * sub + 16 * s2 + 4 * hh;
                    const bf16x8 vf = join8(*(const u32x2*)vp, *(const u32x2*)(vp + 8));
                    o[dt] = mfma32(vf, pf, o[dt]);
                }
            }
        __builtin_amdgcn_sched_group_barrier(0x100, 4, 1);
#pragma unroll
        for (int u = 0; u < 12; ++u) { __builtin_amdgcn_sched_group_barrier(0x008, 1, 1); __builtin_amdgcn_sched_group_barrier(0x100, 1, 1); }
        __builtin_amdgcn_sched_group_barrier(0x008, 4, 1);
    }
    lsum += __shfl_xor(lsum, 32);
    const float inv = 1.f / lsum;
    bf16_t* gp = P + (size_t)qrow * PC + C_GB + h * 64;
#pragma unroll
    for (int dt = 0; dt < 2; ++dt)
#pragma unroll
        for (int g = 0; g < 4; ++g) {
            const int dv = 32 * dt + 8 * g + 4 * hh;
            const f32x4 gate = unpk4(*(const u32x2*)(gp + dv));
            f32x4 y;
#pragma unroll
            for (int jj = 0; jj < 4; ++jj) y[jj] = o[dt][4 * g + jj] * inv * gate[jj];
            if (!dry) *(u32x2*)(gp + dv) = pk4(y);
        }
    __syncthreads();
}

template <int DK, bool RET, bool OUT>
DI void gla_item(const Params& p, int l, int item, unsigned char* smraw, int dry) {
    constexpr int NT = DK / 32, NP = 256 / DK, TP = 32 / NP, PQ = DK + 8, PT = 40;
    const int b = item >> 6, h = (item >> 4) & 3, seg = item & 15;
    const int tid = tid_(), lane = tid & 63, wave = tid >> 6, ql = lane & 31, hh = lane >> 5;
    bf16_t* Qt = (bf16_t*)smraw; bf16_t* Qh = Qt + 32 * PQ; bf16_t* Kt = Qh + 32 * PQ; bf16_t* KhT = Kt + 32 * PQ; bf16_t* VTs = KhT + DK * PT;
    float* tots = (float*)(VTs + 128 * PT); float* decs = tots + NP * DK; float* sums = decs + DK;
    bf16_t* P = (bf16_t*)(p.ws + OFF_P);
    const int tok0 = b * SEQ + seg * 512;
    const int qcol = RET ? C_RQ + h * 64 : C_HQ + h * 128, kcol = RET ? C_RK + h * 64 : C_HZ + h * 128;
    const int vcol = (RET ? C_RV : C_HV) + h * 128, gcol = (RET ? C_RG : C_HG) + h * 128;
    float* U = (float*)(p.ws + (RET ? OFF_RTU : OFF_HGU)); constexpr int USZ = DK * 128;
    float* HB = (float*)(p.ws + OFF_HGB);
    const float lgam = log1pf(-exp2f(-5.f - (float)h));
    f32x16 S[NT];
#pragma unroll
    for (int t = 0; t < NT; ++t)
#pragma unroll
        for (int i = 0; i < 16; ++i) S[t][i] = 0.f;
    if (OUT) {
        float* dall = (float*)smraw;
        if (!RET) {
            for (int e = tid; e < seg * 128; e += 256) dall[e] = __expf(HB[(item - seg) * 128 + e]);
            __syncthreads();
        }
        const float rdec = __expf(512.f * lgam);
#pragma unroll 2
        for (int m = 0; m < seg; ++m) {
            const int it2 = item - seg + m;
#pragma unroll
            for (int t = 0; t < NT; ++t)
#pragma unroll
                for (int i = 0; i < 16; ++i) {
                    const float dec = RET ? rdec : dall[m * 128 + 32 * t + crow(i, hh)];
                    S[t][i] = S[t][i] * dec + U[(size_t)it2 * USZ + (t * 16 + i) * 256 + tid];
                }
        }
    }
    const int d = tid % DK, part = tid / DK;
    const float lbv = RET ? 0.f : ((const float*)(p.ws + OFF_LB))[l * 512 + h * 128 + d];
    float btot_run = 0.f;
    const int vdv = tid & 127, vhalf = tid >> 7;
    unsigned rq[TP], rz[TP], rv[16];
    auto prefetch = [&](int ch) {
        const int t0 = tok0 + ch * 32;
#pragma unroll
        for (int t = 0; t < TP; ++t) {
            const bf16_t* row = P + (size_t)(t0 + part * TP + t) * PC;
            if (OUT) rq[t] = row[qcol + d];
            rz[t] = row[kcol + d];
        }
#pragma unroll
        for (int t = 0; t < 16; ++t) rv[t] = P[(size_t)(t0 + vhalf * 16 + t) * PC + vcol + vdv];
    };
    prefetch(0);
#pragma unroll 1
    for (int ch = 0; ch < 16; ++ch) {
        const int t0 = tok0 + ch * 32;
        float run = 0.f;
        float lfv[TP], kvs[TP];
#pragma unroll
        for (int t = 0; t < TP; ++t) {
            const float z = __uint_as_float(rz[t] << 16);
            if (RET) { kvs[t] = z; lfv[t] = lgam; }
            else {
                const float sg = __builtin_amdgcn_rcpf(1.f + __builtin_amdgcn_exp2f(-1.4426950408889634f * z));
                lfv[t] = __logf(fmaxf(lbv + (1.f - lbv) * sg, 1e-20f));
                kvs[t] = (1.f - lbv) * (1.f - sg);
            }
            run += lfv[t];
        }
        tots[part * DK + d] = run;
        *(u32x4*)(VTs + vdv * PT + vhalf * 16) = (u32x4){rv[0] | (rv[1] << 16), rv[2] | (rv[3] << 16), rv[4] | (rv[5] << 16), rv[6] | (rv[7] << 16)};
        *(u32x4*)(VTs + vdv * PT + vhalf * 16 + 8) = (u32x4){rv[8] | (rv[9] << 16), rv[10] | (rv[11] << 16), rv[12] | (rv[13] << 16), rv[14] | (rv[15] << 16)};
        __syncthreads();
        float base = 0.f, rref = 0.f, blast = 0.f;
#pragma unroll
        for (int pp = 0; pp < NP; ++pp) { const float tt = tots[pp * DK + d]; if (pp < part) base += tt; if (pp < NP / 2) rref += tt; blast += tt; }
        unsigned khp[TP / 2];
        float bt = base;
        const float er = __expf(rref), ebr = __expf(blast - rref);
#pragma unroll
        for (int t = 0; t < TP; ++t) {
            const float kvv = kvs[t];
            bt += lfv[t];
            const int tr = part * TP + t;
            unsigned khb;
            if (OUT) {
                const float qv = __uint_as_float(rq[t] << 16);
                const float e1 = __expf(bt - rref), e2 = __builtin_amdgcn_rcpf(e1);
                Qt[tr * PQ + d] = f2bf(qv * e1);
                Qh[tr * PQ + d] = f2bf(qv * e1 * er);
                Kt[tr * PQ + d] = f2bf(kvv * e2);
                khb = f2bf(kvv * e2 * ebr);
            } else {
                khb = f2bf(kvv * __expf(blast - bt));
            }
            if (t & 1) khp[t >> 1] |= khb << 16; else khp[t >> 1] = khb;
        }
        *(u32x4*)(KhT + d * PT + part * TP) = (u32x4){khp[0], khp[1], khp[2], khp[3]};
        if (TP == 16) *(u32x4*)(KhT + d * PT + part * TP + 8) = (u32x4){khp[TP / 2 - 4], khp[TP / 2 - 3], khp[TP / 2 - 2], khp[TP / 2 - 1]};
        if (part == 0) { decs[d] = __expf(blast); btot_run += blast; }
        if (ch + 1 < 16) prefetch(ch + 1);
        __syncthreads();
        f32x16 o;
        u32x2 gate_r[4];
        if (OUT) {
#pragma unroll
            for (int g = 0; g < 4; ++g) gate_r[g] = *(const u32x2*)(P + (size_t)(t0 + ql) * PC + gcol + 32 * wave + 8 * g + 4 * hh);
        }
        if (OUT) {
            f32x16 at;
#pragma unroll
            for (int i = 0; i < 16; ++i) { at[i] = 0.f; o[i] = 0.f; }
#pragma unroll
            for (int ks = 0; ks < DK / 16; ++ks) {
                const bf16x8 kf = *(const bf16x8*)(Kt + ql * PQ + 16 * ks + 8 * hh);
                const bf16x8 qf = *(const bf16x8*)(Qt + ql * PQ + 16 * ks + 8 * hh);
                at = mfma32(kf, qf, at);
            }
#pragma unroll
            for (int i = 0; i < 16; ++i) if (crow(i, hh) > ql) at[i] = 0.f;
#pragma unroll
            for (int s2 = 0; s2 < 2; ++s2) {
                const bf16x8 pa = pack8(at[8 * s2], at[8 * s2 + 1], at[8 * s2 + 2], at[8 * s2 + 3], at[8 * s2 + 4], at[8 * s2 + 5], at[8 * s2 + 6], at[8 * s2 + 7]);
                const bf16_t* vp = VTs + (32 * wave + ql) * PT + 16 * s2 + 4 * hh;
                o = mfma32(join8(*(const u32x2*)vp, *(const u32x2*)(vp + 8)), pa, o);
            }
#pragma unroll
            for (int t = 0; t < NT; ++t)
#pragma unroll
                for (int s2 = 0; s2 < 2; ++s2) {
                    const bf16x8 sf = pack8(S[t][8 * s2], S[t][8 * s2 + 1], S[t][8 * s2 + 2], S[t][8 * s2 + 3], S[t][8 * s2 + 4], S[t][8 * s2 + 5], S[t][8 * s2 + 6], S[t][8 * s2 + 7]);
                    const bf16_t* qp = Qh + ql * PQ + 32 * t + 16 * s2 + 4 * hh;
                    o = mfma32(sf, join8(*(const u32x2*)qp, *(const u32x2*)(qp + 8)), o);
                }
        }
#pragma unroll
        for (int t = 0; t < NT; ++t) {
#pragma unroll
            for (int i = 0; i < 16; ++i) S[t][i] *= decs[32 * t + crow(i, hh)];
#pragma unroll
            for (int s2 = 0; s2 < 2; ++s2) {
                const bf16x8 kf = *(const bf16x8*)(KhT + (32 * t + ql) * PT + 16 * s2 + 8 * hh);
                const bf16x8 vf = *(const bf16x8*)(VTs + (32 * wave + ql) * PT + 16 * s2 + 8 * hh);
                S[t] = mfma32(kf, vf, S[t]);
            }
        }
        if (OUT) {
            float ss = 0.f;
#pragma unroll
            for (int i = 0; i < 16; ++i) ss += o[i] * o[i];
            ss += __shfl_xor(ss, 32);
            if (hh == 0) sums[wave * 32 + ql] = ss;
            __syncthreads();
            const float tot = sums[ql] + sums[32 + ql] + sums[64 + ql] + sums[96 + ql];
            const float rstd = rsqrtf(tot * (1.f / 128.f) + EPSF);
            bf16_t* gp = P + (size_t)(t0 + ql) * PC + gcol;
#pragma unroll
            for (int g = 0; g < 4; ++g) {
                const int dv = 32 * wave + 8 * g + 4 * hh;
                const f32x4 gate = unpk4(gate_r[g]);
                f32x4 y;
#pragma unroll
                for (int jj = 0; jj < 4; ++jj) { const float gn = RET ? 1.f : p.hg_onorm[l * 128 + dv + jj]; y[jj] = o[4 * g + jj] * rstd * gn * gate[jj]; }
                if (!dry) *(u32x2*)(gp + dv) = pk4(y);
            }
        } else {
            __syncthreads();
        }
    }
    if (!OUT) {
#pragma unroll
        for (int t = 0; t < NT; ++t)
#pragma unroll
            for (int i = 0; i < 16; ++i) U[(size_t)item * USZ + (t * 16 + i) * 256 + tid] = S[t][i];
        if (!RET && part == 0) HB[item * 128 + d] = btot_run;
    }
    __syncthreads();
}

DI void merge_item(const Params& p, int mt, int nt, unsigned char* smb) {
    const int m0 = mt * 256, n0 = nt * 128;
    f32x4 am[4][4]; zero_acc<4, 4>(am);
    const bf16_t* H = (const bf16_t*)(p.ws + OFF_H) + (size_t)m0 * 1024;
    bf16_t* P = (bf16_t*)(p.ws + OFF_P);
#pragma unroll 1
    for (int br = 0; br < 3; ++br) {
        const int ycol = br == 0 ? C_HG : (br == 1 ? C_GB : C_RG);
        u32x2 sg[4][4];
        { f32x4 ag[4][4]; zero_acc<4, 4>(ag);
          gemm8<4, 4, 2>(H, 1024, (const bf16_t*)(p.ws + OFF_WM) + (size_t)(br * 1024 + n0) * 1024, 1024, 1024, ag, smb);
#pragma unroll
          for (int i = 0; i < 4; ++i)
#pragma unroll
              for (int j = 0; j < 4; ++j) { f32x4 g;
#pragma unroll
                  for (int jj = 0; jj < 4; ++jj) g[jj] = sigmoidf_(ag[i][j][jj]);
                  sg[i][j] = pk4(g); } }
        f32x4 ay[4][4]; zero_acc<4, 4>(ay);
        gemm8<4, 4, 2>(P + (size_t)m0 * PC + ycol, PC, (const bf16_t*)(p.ws + OFF_WP) + (size_t)br * 1024 * 512 + (size_t)n0 * 512, 512, 512, ay, smb);
#pragma unroll
        for (int i = 0; i < 4; ++i)
#pragma unroll
            for (int j = 0; j < 4; ++j) { const f32x4 g = unpk4(sg[i][j]);
#pragma unroll
                for (int jj = 0; jj < 4; ++jj) am[i][j][jj] += g[jj] * ay[i][j][jj]; }
    }
    const int tid = tid8_(), lane = tid & 63, wave = tid >> 6, wm = wave >> 1, wn = wave & 1, fr = lane & 15, fq = lane >> 4;
#pragma unroll
    for (int i = 0; i < 4; ++i) {
        const int row = m0 + 64 * wm + 16 * i + fr;
#pragma unroll
        for (int j = 0; j < 4; ++j) *(u32x2*)(P + (size_t)row * PC + n0 + 64 * wn + 16 * j + 4 * fq) = pk4(am[i][j]);
    }
}

DI void out_item(const Params& p, int l, int mt, int nt, unsigned char* smb, int dry) {
    const int m0 = mt * 256, n0 = nt * 256;
    f32x4 acc[8][4]; zero_acc<8, 4>(acc);
    gemm8<8, 4, 4>((const bf16_t*)(p.ws + OFF_P) + (size_t)m0 * PC, PC, (const bf16_t*)(p.ws + OFF_WOUT) + (size_t)n0 * 1024, 1024, 1024, acc, smb);
    const int tid = tid8_(), lane = tid & 63, wave = tid >> 6, wm = wave >> 2, wn = wave & 3, fr = lane & 15, fq = lane >> 4;
    const float* xin = l == 0 ? p.x : p.out;
#pragma unroll
    for (int i = 0; i < 8; ++i) {
        const int row = m0 + 128 * wm + 16 * i + fr, b = row >> 13;
        const float* gate = (const float*)(p.ws + OFF_MOD) + (l * 2 + b) * 3072 + 2048;
#pragma unroll
        for (int j = 0; j < 4; ++j) {
            const int col = n0 + 64 * wn + 16 * j + 4 * fq;
            const f32x4 xo = *(const f32x4*)(xin + (size_t)row * 1024 + col), g = *(const f32x4*)(gate + col);
            f32x4 r;
#pragma unroll
            for (int jj = 0; jj < 4; ++jj) r[jj] = xo[jj] + g[jj] * acc[i][j][jj];
            if (!dry) *(f32x4*)(p.out + (size_t)row * 1024 + col) = r;
        }
    }
}

constexpr int LDS_BYTES = 131072, HALF_LDS = 65536;
constexpr int N_PHASES = 14;
DI void phase_prep(const Params& p, unsigned char* sm) {
    const int bid = blockIdx.x, G = gridDim.x, vb = vb_();
    unsigned char* smv = sm + vb * HALF_LDS;
    if (bid == 0) { const int t = tid8_(); if (t < 256) ((unsigned*)p.ws)[t] = 0u; }
    if (bid == G - 1 && vb == 1) lb_item(p);
#pragma unroll 1
    for (int k = bid; k < 96; k += G) mod_item(p, 2 * k + vb, (float*)smv);
}
DI void phase_final(const Params& p) { for (int it = 2 * blockIdx.x + vb_(); it < 4096; it += 2 * gridDim.x) final_item(p, it); }
template <int SP> DI void layer_phase(const Params& p, int l, unsigned char* sm, int dry, int qidx) {
    const int bid = blockIdx.x, G = gridDim.x, vb = vb_();
    unsigned char* smv = sm + vb * HALF_LDS;
    if (SP == 0) {
#pragma unroll 4
        for (int it = 2 * bid + vb; it < 4096; it += 2 * G) norm_item(p, l, it);
#pragma unroll 1
        for (int k = G - 1 - bid; k < CONV_ITEMS / 2; k += G) conv_weights(p, l, 2 * k + vb, (float*)smv);
    } else if (SP == 1) {
#pragma unroll 1
        for (int q = bid >> 3; q < 8 * INPROJ_NT; q += (G >> 3)) inproj_item(p, 8 * (bid & 7) + (q & 7), q >> 3, sm, dry);
    } else if (SP == 2) {
        const int xcd = bid & 7, nq = G >> 3;
        unsigned* ctr = (unsigned*)p.ws + qidx + xcd * 2;
        int it = bid >> 3;
#pragma unroll 1
        for (;;) {
            if (it >= 88) break;
            if (it < 8) { for (int r = 0; r < REPG2; ++r) gla_item<128, false, false>(p, l, 2 * (xcd * 8 + it) + vb, smv, dry); }
            else if (it < 16) { for (int r = 0; r < REPG2; ++r) gla_item<64, true, false>(p, l, 2 * (xcd * 8 + it - 8) + vb, smv, dry); }
            else if (it < 24) kr_item(p, xcd * 8 + it - 16);
            else if (it < 56) { for (int r = 0; r < REPQ2; ++r) qup_item(p, xcd * 32 + it - 24, (bf16_t*)sm, dry | (r + 1 < REPQ2)); }
            else { const int t = xcd * 32 + it - 56; for (int r = 0; r < REPK2; ++r) kvup_item(p, t >> 2, t & 3, sm); }
            it = nq + grab_item(ctr, sm);
        }
    } else if (SP == 3) {
        const int xcd = bid & 7;
        unsigned* ctr = (unsigned*)p.ws + qidx + xcd * 2;
        int it = bid >> 3;
#pragma unroll 1
        for (;; it = (G >> 3) + grab_item(ctr, sm)) {
            if (it >= 80) break;
            if (it < 8) { for (int r = 0; r < REPG3; ++r) gla_item<128, false, true>(p, l, 2 * (xcd * 8 + it) + vb, smv, dry | (r + 1 < REPG3)); }
            else if (it < 16) { for (int r = 0; r < REPG3; ++r) gla_item<64, true, true>(p, l, 2 * (xcd * 8 + it - 8) + vb, smv, dry | (r + 1 < REPG3)); }
            else { for (int r = 0; r < REPA3; ++r) attn_item(p, 31 - ((it - 16) >> 1), 2 * xcd + ((it - 16) & 1), (bf16_t*)sm, dry | (r + 1 < REPA3)); }
        }
    } else if (SP == 4) {
#pragma unroll 1
        for (int q = bid >> 3; q < 8 * 8; q += (G >> 3)) merge_item(p, 8 * (bid & 7) + (q & 7), q >> 3, sm);
    } else {
#pragma unroll 1
        for (int q = bid >> 3; q < 8 * 4; q += (G >> 3)) out_item(p, l, 8 * (bid & 7) + (q & 7), q >> 3, sm, dry);
    }
}

#if ONE_LAUNCH
__global__ void __launch_bounds__(512, 2) __attribute__((amdgpu_waves_per_eu(2, 2))) fwd_megakernel(Params p) {
    extern __shared__ __attribute__((aligned(1024))) unsigned char sm[];
    cg::grid_group grid = cg::this_grid();
    unsigned* gbar = (unsigned*)(p.ws + OFF_BAR); unsigned gk = 0;
    phase_prep(p, sm); grid.sync();
#define RUN_PH(SP, L, REP) for (int rep = 0; rep < (REP); ++rep) { int dry = (rep + 1 < (REP)) ? 1 : 0; asm volatile("" : "+s"(dry)); layer_phase<SP>(p, L, sm, dry, (L) * 128 + (SP) * 16 + rep); grid_barrier(gbar, ++gk); }
    RUN_PH(0, 0, REP0) RUN_PH(1, 0, REP1) RUN_PH(2, 0, REP2) RUN_PH(3, 0, REP3) RUN_PH(4, 0, REP4) RUN_PH(5, 0, REP5)
    RUN_PH(0, 1, REP0) RUN_PH(1, 1, REP1) RUN_PH(2, 1, REP2) RUN_PH(3, 1, REP3) RUN_PH(4, 1, REP4) RUN_PH(5, 1, REP5)
    phase_final(p);
}
#else
__global__ void __launch_bounds__(512, 2) phase_kernel(Params p, int ph) {
    extern __shared__ __attribute__((aligned(1024))) unsigned char sm[];
    if (ph == 0) { phase_prep(p, sm); return; }
    if (ph == 13) { phase_final(p); return; }
    const int l = (ph - 1) / 6, sp = (ph - 1) % 6;
    if (sp == 0) layer_phase<0>(p, l, sm, 0, l * 128 + 0 * 16); else if (sp == 1) layer_phase<1>(p, l, sm, 0, l * 128 + 1 * 16); else if (sp == 2) layer_phase<2>(p, l, sm, 0, l * 128 + 2 * 16);
    else if (sp == 3) layer_phase<3>(p, l, sm, 0, l * 128 + 3 * 16); else if (sp == 4) layer_phase<4>(p, l, sm, 0, l * 128 + 4 * 16); else layer_phase<5>(p, l, sm, 0, l * 128 + 5 * 16);
}
#endif

extern "C" void kernel_launch(void* const* d_in, const int* in_sizes, int n_in, void* d_out, int out_size, void* d_ws, size_t ws_size, hipStream_t stream) {
    Params p{};
    p.x = (const float*)d_in[0]; p.c = (const float*)d_in[1]; p.pos = (const int*)d_in[2]; p.norm_g = (const float*)d_in[3];
    p.w_mod = (const float*)d_in[4]; p.b_mod = (const float*)d_in[5]; p.w_in = (const float*)d_in[6]; p.hg_lb = (const float*)d_in[7];
    p.hg_onorm = (const float*)d_in[8]; p.g_cq = (const float*)d_in[9]; p.w_uq = (const float*)d_in[10]; p.g_ckv = (const float*)d_in[11];
    p.w_ukv = (const float*)d_in[12]; p.w_pa = (const float*)d_in[13]; p.w_pb = (const float*)d_in[14]; p.w_pc = (const float*)d_in[15];
    p.w_out = (const float*)d_in[16]; p.final_g = (const float*)d_in[17];
    p.out = (float*)d_out; p.ws = (unsigned char*)d_ws;
#if ONE_LAUNCH
    static int grid_blocks = 0;
    if (!grid_blocks) {
        int dev = 0, cus = 0, per_cu = 0;
        (void)hipGetDevice(&dev);
        (void)hipDeviceGetAttribute(&cus, hipDeviceAttributeMultiprocessorCount, dev);
        if (hipFuncSetAttribute((const void*)fwd_megakernel, hipFuncAttributeMaxDynamicSharedMemorySize, LDS_BYTES) != hipSuccess)
            fprintf(stderr, "hipFuncSetAttribute(MaxDynamicSharedMemorySize=%d) failed\n", LDS_BYTES);
        (void)hipOccupancyMaxActiveBlocksPerMultiprocessor(&per_cu, fwd_megakernel, 512, LDS_BYTES);
        if (per_cu < 1) per_cu = 1;
        if (per_cu > 1) per_cu = 1;
        grid_blocks = (cus / 8) * 8 * per_cu;
    }
    (void)hipMemsetAsync((unsigned char*)d_ws + OFF_BAR, 0, BAR_BYTES, stream);
    void* args[] = {&p};
    hipError_t e = hipLaunchCooperativeKernel((void*)fwd_megakernel, dim3(grid_blocks), dim3(512), args, LDS_BYTES, stream);
    if (e != hipSuccess) fprintf(stderr, "cooperative launch failed: %s (grid %d)\n", hipGetErrorString(e), grid_blocks);
#else
    (void)hipFuncSetAttribute((const void*)phase_kernel, hipFuncAttributeMaxDynamicSharedMemorySize, LDS_BYTES);
    for (int ph = 0; ph < N_PHASES; ++ph) phase_kernel<<<256, 512, LDS_BYTES, stream>>>(p, ph);
#endif
}
```

```cpp
#include <hip/hip_runtime.h>
#include <hip/hip_cooperative_groups.h>
#include <cstdio>
#include <cstdint>
namespace cg = cooperative_groups;

#define DI __device__ __forceinline__
typedef unsigned short bf16_t;
typedef short bf16x8 __attribute__((ext_vector_type(8)));
typedef float f32x4 __attribute__((ext_vector_type(4)));
typedef float f32x16 __attribute__((ext_vector_type(16)));
typedef float f32x2 __attribute__((ext_vector_type(2)));
typedef unsigned u32x2 __attribute__((ext_vector_type(2)));
typedef unsigned u32x4 __attribute__((ext_vector_type(4)));
typedef __bf16 bf16x2_t __attribute__((ext_vector_type(2)));

#ifndef ONE_LAUNCH
#define ONE_LAUNCH 1
#endif
#define REP0 1
#define REP1 1
#define REP2 1
#define REP3 1
#define REP4 1
#define REP5 1
#define REPG3 1
#define REPA3 1
#define REPG2 1
#define REPQ2 1
#define REPK2 1

constexpr int SEQ = 8192, NTOK = 16384, DM = 1024;
constexpr int PC = 5152;
constexpr int DIN = 8224;
constexpr int C_HQ = 0, C_HZ = 512, C_HV = 1024, C_HG = 1536, C_CQ = 2048, C_CKV = 2816, C_GB = 3072,
              C_RQ = 3584, C_RK = 3840, C_RV = 4096, C_RG = 4608, C_KR = 5120;
constexpr float EPSF = 1e-6f;
constexpr float LOG2_1E4 = 13.287712379549449f;
constexpr float QSCALE = 0.10206207261596577f * 1.4426950408889634f;

constexpr size_t OFF_MOD = 4096;
constexpr size_t OFF_LB  = OFF_MOD + 2 * 2 * 3072 * 4;
constexpr size_t OFF_SSQ = OFF_LB + 2 * 512 * 4;
constexpr size_t OFF_HGB = OFF_SSQ + 16384 * 2 * 4;
constexpr size_t OFF_HGU = 262144;
constexpr size_t OFF_RTU = OFF_HGU + 128ull * 16384 * 4;
constexpr size_t OFF_WM  = OFF_RTU + 128ull * 8192 * 4;
constexpr size_t OFF_WUQ = OFF_WM + 3072ull * 1024 * 2;
constexpr size_t OFF_WUKV = OFF_WUQ + 768ull * 768 * 2;
constexpr size_t OFF_WP  = OFF_WUKV + 1024ull * 256 * 2;
constexpr size_t OFF_WOUT = OFF_WP + 3ull * 1024 * 512 * 2;
constexpr size_t OFF_H   = OFF_WOUT + 1024ull * 1024 * 2;
constexpr size_t OFF_P   = OFF_H + 16384ull * 1024 * 2;
constexpr size_t OFF_KN  = OFF_P + 16384ull * PC * 2;
constexpr size_t OFF_VT  = OFF_KN + 16384ull * 512 * 2;
constexpr size_t OFF_WKR = OFF_VT + 16384ull * 512 * 2;
constexpr size_t OFF_BAR = OFF_WKR + 32ull * 1024 * 2;
constexpr size_t BAR_BYTES = 8192;
constexpr size_t WS_END  = OFF_BAR + BAR_BYTES;
static_assert(OFF_HGB + 128 * 128 * 4 <= OFF_HGU, "ws map");
static_assert(WS_END <= 268435456ull, "workspace too large");
static_assert(OFF_P % 256 == 0 && OFF_KN % 256 == 0 && OFF_H % 256 == 0, "align");

struct Params {
    const float* x; const float* c; const int* pos; const float* norm_g; const float* w_mod; const float* b_mod; const float* w_in;
    const float* hg_lb; const float* hg_onorm; const float* g_cq; const float* w_uq; const float* g_ckv; const float* w_ukv;
    const float* w_pa; const float* w_pb; const float* w_pc; const float* w_out; const float* final_g;
    float* out; unsigned char* ws;
};


DI float bf2f(bf16_t v) { return __uint_as_float(((unsigned)v) << 16); }
DI unsigned pk2(float lo, float hi) { f32x2 v = {lo, hi}; bf16x2_t b = __builtin_convertvector(v, bf16x2_t); return __builtin_bit_cast(unsigned, b); }
DI bf16_t f2bf(float v) { return (bf16_t)(pk2(v, 0.f) & 0xffffu); }
DI u32x2 pk4(f32x4 v) { u32x2 r; r.x = pk2(v[0], v[1]); r.y = pk2(v[2], v[3]); return r; }
DI f32x4 unpk4(u32x2 u) { f32x4 r; r[0] = __uint_as_float(u.x << 16); r[1] = __uint_as_float(u.x & 0xffff0000u); r[2] = __uint_as_float(u.y << 16); r[3] = __uint_as_float(u.y & 0xffff0000u); return r; }
DI float sigmoidf_(float v) { return __builtin_amdgcn_rcpf(1.f + __builtin_amdgcn_exp2f(-1.4426950408889634f * v)); }
DI float siluf_(float v) { return v * __builtin_amdgcn_rcpf(1.f + __builtin_amdgcn_exp2f(-1.4426950408889634f * v)); }
DI int tid8_() { int t = threadIdx.x; asm volatile("" : "+v"(t)); return t; }
DI int tid_() { return tid8_() & 255; }
DI int vb_() { return __builtin_amdgcn_readfirstlane(tid8_() >> 8); }
DI int grab_item(unsigned* ctr, unsigned char* sm) {
    __syncthreads();
    if (tid8_() == 0) *(volatile int*)sm = (int)atomicAdd(ctr, 1u);
    __syncthreads();
    const int it = *(volatile int*)sm;
    __syncthreads();
    return it;
}
#define GB_GRP(g)  (64u * (1u + (g)))
#define GB_GGEN(g) (64u * (9u + (g)))
#define GB_TOP     (64u * 17u)
#define GB_TOPGEN  (64u * 18u)
DI unsigned gb_ld(unsigned* p) { return __hip_atomic_load(p, __ATOMIC_RELAXED, __HIP_MEMORY_SCOPE_AGENT); }
DI unsigned gb_add(unsigned* p) { return __hip_atomic_fetch_add(p, 1u, __ATOMIC_RELAXED, __HIP_MEMORY_SCOPE_AGENT); }
DI void grid_barrier(unsigned* bar, unsigned k) {
    asm volatile("s_waitcnt vmcnt(0)" ::: "memory");
    __syncthreads();
    if (tid8_() == 0) {
        const unsigned g = blockIdx.x & 7u, nloc = gridDim.x >> 3;
        __builtin_amdgcn_fence(__ATOMIC_RELEASE, "agent");
        asm volatile("s_waitcnt vmcnt(0)" ::: "memory");
        const unsigned old = gb_add(&bar[GB_GRP(g)]);
        if (old + 1u == k * nloc) {
            const unsigned og = gb_add(&bar[GB_TOP]);
            if (og + 1u == k * 8u) gb_add(&bar[GB_TOPGEN]);
            else while (gb_ld(&bar[GB_TOPGEN]) < k) __builtin_amdgcn_s_sleep(1);
            gb_add(&bar[GB_GGEN(g)]);
        } else {
            while (gb_ld(&bar[GB_GGEN(g)]) < k) __builtin_amdgcn_s_sleep(2);
        }
        __builtin_amdgcn_fence(__ATOMIC_ACQUIRE, "agent");
        asm volatile("s_waitcnt vmcnt(0)" ::: "memory");
    }
    __syncthreads();
}
DI int crow(int i, int hh) { return (i & 3) + 8 * (i >> 2) + 4 * hh; }
DI f32x16 mfma32(bf16x8 a, bf16x8 b, f32x16 c) { return __builtin_amdgcn_mfma_f32_32x32x16_bf16(a, b, c, 0, 0, 0); }
DI f32x4 mfma16(bf16x8 a, bf16x8 b, f32x4 c) { return __builtin_amdgcn_mfma_f32_16x16x32_bf16(a, b, c, 0, 0, 0); }
DI bf16x8 pack8(float a0, float a1, float a2, float a3, float a4, float a5, float a6, float a7) {
    u32x4 u; u.x = pk2(a0, a1); u.y = pk2(a2, a3); u.z = pk2(a4, a5); u.w = pk2(a6, a7); return __builtin_bit_cast(bf16x8, u);
}
DI bf16x8 join8(u32x2 lo, u32x2 hi) { u32x4 u; u.x = lo.x; u.y = lo.y; u.z = hi.x; u.w = hi.y; return __builtin_bit_cast(bf16x8, u); }
DI float warp_sum(float v) {
#pragma unroll
    for (int o = 32; o > 0; o >>= 1) v += __shfl_xor(v, o);
    return v;
}
DI void rope2(float& a, float& b, float ang) {
    const float n = rintf(ang * 0.15915493667125702f);
    float r = __builtin_fmaf(ang, 0.15915493667125702f, -n);
    r = __builtin_fmaf(ang, 6.4206382432985265e-09f, r);
    const float s = __builtin_amdgcn_sinf(r), c = __builtin_amdgcn_cosf(r);
    const float x1 = a, x2 = b; a = x1 * c - x2 * s; b = x2 * c + x1 * s;
}

DI int perm32(int rho) { return 8 * ((rho & 15) >> 2) + 4 * (rho >> 4) + (rho & 3); }
template <bool FRAG = false, bool PERM = false>
DI void conv_tile(const float* __restrict__ src, int ldsrc, int srccol0, int k0, bf16_t* dst, int lddst, int n0,
                  const float* __restrict__ rowscale, float sc, float* sm) {
    const int tid = tid_(), nn = tid & 31, kk0 = tid >> 5;
#pragma unroll 4
    for (int i = 0; i < 16; ++i) {
        const int kk = kk0 + 8 * i;
        float v = src[(size_t)(k0 + kk) * ldsrc + srccol0 + nn];
        if (rowscale) v *= rowscale[k0 + kk];
        sm[kk * 33 + nn] = v * sc;
    }
    __syncthreads();
    const int kp = 2 * (tid & 63), nb = tid >> 6;
#pragma unroll
    for (int i = 0; i < 8; ++i) {
        const int n = nb + 4 * i;
        const int ng = n0 + n, kg = k0 + kp;
        const size_t off = FRAG ? ((size_t)((ng >> 4) * (lddst >> 5) + (kg >> 5)) * 512 + (((ng & 15) + 16 * ((kg >> 3) & 3)) << 3) + (kg & 7)) : ((size_t)ng * lddst + kg);
        const int ns = PERM ? perm32(n) : n;
        *(unsigned*)(dst + off) = pk2(sm[kp * 33 + ns], sm[(kp + 1) * 33 + ns]);
    }
    __syncthreads();
}

constexpr int CONV_ITEMS = 1288 + 768 + 144 + 64 + 384 + 256;
DI void conv_weights(const Params& p, int l, int item, float* sm) {
    unsigned char* ws = p.ws;
    const float* w_in = p.w_in + (size_t)l * 1024 * DIN;
    if (item < 1288) { const int n0 = (item >> 3) * 32, kb = item & 7; const int sc0 = n0 < 3072 ? n0 : (n0 < 5120 ? n0 + 32 : 3072);
        if (n0 >= 5120) conv_tile(w_in, DIN, sc0, kb * 128, (bf16_t*)(ws + OFF_WKR), 1024, n0 - 5120, nullptr, 1.f, sm);
        else conv_tile<false, true>(w_in, DIN, sc0, kb * 128, (bf16_t*)(ws + OFF_KN), 1024, n0, nullptr, 1.f, sm);
        return; }
    item -= 1288;
    if (item < 768) { const int n0 = (item >> 3) * 32, kb = item & 7;
        conv_tile(w_in, DIN, 5152 + n0, kb * 128, (bf16_t*)(ws + OFF_WM), 1024, n0, nullptr, 1.f, sm); return; }
    item -= 768;
    if (item < 144) { const int n0 = (item / 6) * 32, kb = item % 6; const int sc0 = n0 < 512 ? (n0 >> 6) * 96 + (n0 & 63) : ((n0 - 512) >> 5) * 96 + 64;
        conv_tile<true>(p.w_uq + (size_t)l * 768 * 768, 768, sc0, kb * 128, (bf16_t*)(ws + OFF_WUQ), 768, n0, p.g_cq + l * 768, QSCALE, sm); return; }
    item -= 144;
    if (item < 64) { const int n0 = (item >> 1) * 32, kb = item & 1;
        conv_tile(p.w_ukv + (size_t)l * 256 * 1024, 1024, n0, kb * 128, (bf16_t*)(ws + OFF_WUKV), 256, n0, p.g_ckv + l * 256, 1.f, sm); return; }
    item -= 64;
    if (item < 384) { const int br = item >> 7, r = item & 127, n0 = (r >> 2) * 32, kb = r & 3;
        const float* w = (br == 0 ? p.w_pa : (br == 1 ? p.w_pb : p.w_pc)) + (size_t)l * 512 * 1024;
        conv_tile(w, 1024, n0, kb * 128, (bf16_t*)(ws + OFF_WP) + (size_t)br * 1024 * 512, 512, n0, nullptr, 1.f, sm); return; }
    item -= 384;
    { const int n0 = (item >> 3) * 32, kb = item & 7;
        conv_tile(p.w_out + (size_t)l * 1024 * 1024, 1024, n0, kb * 128, (bf16_t*)(ws + OFF_WOUT), 1024, n0, nullptr, 1.f, sm); }
}

DI void mod_item(const Params& p, int item, float* sm) {
    const int l = item / 96, n0 = (item % 96) * 32, tid = tid_(), nn = tid & 31, ks = tid >> 5;
    float* sc = sm + 1024;
    for (int e = tid; e < 2048; e += 256) sc[e] = siluf_(p.c[e]);
    __syncthreads();
    const float* w = p.w_mod + (size_t)l * 1024 * 3072 + n0 + nn + (size_t)(ks * 128) * 3072;
    float s0 = 0.f, s1 = 0.f;
#pragma unroll 1
    for (int k0 = 0; k0 < 128; k0 += 16) {
        float wv[16];
#pragma unroll
        for (int u = 0; u < 16; ++u) wv[u] = w[(size_t)(k0 + u) * 3072];
#pragma unroll
        for (int u = 0; u < 16; ++u) { s0 += sc[ks * 128 + k0 + u] * wv[u]; s1 += sc[1024 + ks * 128 + k0 + u] * wv[u]; }
    }
    sm[(ks * 32 + nn) * 2] = s0; sm[(ks * 32 + nn) * 2 + 1] = s1;
    __syncthreads();
    if (tid < 64) { const int n = tid & 31, b = tid >> 5; float s = 0.f;
        for (int q = 0; q < 8; ++q) s += sm[(q * 32 + n) * 2 + b];
        ((float*)(p.ws + OFF_MOD))[(l * 2 + b) * 3072 + n0 + n] = s + p.b_mod[l * 3072 + n0 + n]; }
    __syncthreads();
}
DI void lb_item(const Params& p) {
    float* LB = (float*)(p.ws + OFF_LB);
    for (int ch = tid_(); ch < 512; ch += 256) {
        const float l0 = p.hg_lb[ch], l1 = p.hg_lb[512 + ch];
        LB[ch] = 0.f; LB[512 + ch] = 1.f / (1.f + expf(l0 - l1));
    }
}

DI void norm_item(const Params& p, int l, int item) {
    const int tid__ = tid_(), lane = tid__ & 63, row = item * 4 + (tid__ >> 6), b = row >> 13;
    const float* xin = (l == 0 ? p.x : p.out) + (size_t)row * 1024;
    f32x4 v[4]; float ss = 0.f;
#pragma unroll
    for (int i = 0; i < 4; ++i) { v[i] = *(const f32x4*)(xin + lane * 4 + 256 * i); ss += v[i][0] * v[i][0] + v[i][1] * v[i][1] + v[i][2] * v[i][2] + v[i][3] * v[i][3]; }
    ss = warp_sum(ss);
    const float rstd = rsqrtf(ss * (1.f / 1024.f) + EPSF);
    const float* mod = (const float*)(p.ws + OFF_MOD) + (l * 2 + b) * 3072;
    bf16_t* h = (bf16_t*)(p.ws + OFF_H) + (size_t)row * 1024;
#pragma unroll
    for (int i = 0; i < 4; ++i) {
        const int col = lane * 4 + 256 * i;
        const f32x4 g = *(const f32x4*)(p.norm_g + l * 1024 + col), sh = *(const f32x4*)(mod + col), sc = *(const f32x4*)(mod + 1024 + col);
        f32x4 o;
#pragma unroll
        for (int j = 0; j < 4; ++j) o[j] = v[i][j] * rstd * g[j] * (1.f + sc[j]) + sh[j];
        *(u32x2*)(h + col) = pk4(o);
    }
    if (lane == 0) { float* ssq = (float*)(p.ws + OFF_SSQ) + row * 2; ssq[0] = 0.f; ssq[1] = 0.f; }
}
DI void final_item(const Params& p, int item) {
    const int tid__ = tid_(), lane = tid__ & 63, row = item * 4 + (tid__ >> 6);
    float* xr = p.out + (size_t)row * 1024;
    f32x4 v[4]; float ss = 0.f;
#pragma unroll
    for (int i = 0; i < 4; ++i) { v[i] = *(const f32x4*)(xr + lane * 4 + 256 * i); ss += v[i][0] * v[i][0] + v[i][1] * v[i][1] + v[i][2] * v[i][2] + v[i][3] * v[i][3]; }
    ss = warp_sum(ss);
    const float rstd = rsqrtf(ss * (1.f / 1024.f) + EPSF);
#pragma unroll
    for (int i = 0; i < 4; ++i) {
        const int col = lane * 4 + 256 * i; const f32x4 g = *(const f32x4*)(p.final_g + col);
        f32x4 o;
#pragma unroll
        for (int j = 0; j < 4; ++j) o[j] = v[i][j] * rstd * g[j];
        *(f32x4*)(xr + col) = o;
    }
}

template <int MT, int NT, int WN>
DI void gemm8(const bf16_t* A, int lda, const bf16_t* Bt, int ldb, int K, f32x4 (&acc)[MT][NT], unsigned char* smb) {
    constexpr int WM = 8 / WN, BM = 16 * MT * WM, BN = 16 * NT * WN;
    static_assert(BM == 256, "block tile is 256 rows");
    constexpr int A_B = BM * 128, B_B = BN * 128, ST_B = A_B + B_B, NA = BM / 64, NB = BN / 64;
    const int tid = tid8_(), lane = tid & 63, wave = tid >> 6, wm = wave / WN, wn = wave % WN;
    const int fr = lane & 15, fq = lane >> 4, lr = lane >> 3, pc = lane & 7;
    const bf16_t* ag[NA]; const bf16_t* bg[NB];
#pragma unroll
    for (int i = 0; i < NA; ++i) { const int row = 8 * (8 * i + wave) + lr, c = pc ^ ((row >> 1) & 7); ag[i] = A + (size_t)row * lda + c * 8; }
#pragma unroll
    for (int i = 0; i < NB; ++i) { const int row = 8 * (8 * i + wave) + lr, c = pc ^ ((row >> 1) & 7); bg[i] = Bt + (size_t)row * ldb + c * 8; }
    auto stage = [&](int buf, int ko) {
#pragma unroll
        for (int i = 0; i < NA; ++i) __builtin_amdgcn_global_load_lds((const unsigned*)(ag[i] + ko), (unsigned*)(smb + buf * ST_B + (8 * i + wave) * 1024), 16, 0, 0);
#pragma unroll
        for (int i = 0; i < NB; ++i) __builtin_amdgcn_global_load_lds((const unsigned*)(bg[i] + ko), (unsigned*)(smb + buf * ST_B + A_B + (8 * i + wave) * 1024), 16, 0, 0);
    };
    const int KT = K >> 6;
    const int swz = fr >> 1;
    const int aoff = (16 * MT * wm + fr) * 128, boff = A_B + (16 * NT * wn + fr) * 128;
    stage(0, 0);
    asm volatile("s_waitcnt vmcnt(0)" ::: "memory");
    __syncthreads();
#pragma unroll 1
    for (int kt = 0; kt < KT; ++kt) {
        const int cur = kt & 1;
        if (kt + 1 < KT) stage(cur ^ 1, (kt + 1) * 64);
        const unsigned char* sb = smb + cur * ST_B;
#pragma unroll
        for (int ks = 0; ks < 2; ++ks) {
            const int co = ((4 * ks + fq) ^ swz) << 4;
            bf16x8 af[MT], bf[NT];
#pragma unroll
            for (int i = 0; i < MT; ++i) af[i] = *(const bf16x8*)(sb + aoff + i * 2048 + co);
#pragma unroll
            for (int j = 0; j < NT; ++j) bf[j] = *(const bf16x8*)(sb + boff + j * 2048 + co);
#pragma unroll
            for (int i = 0; i < MT; ++i)
#pragma unroll
                for (int j = 0; j < NT; ++j) acc[i][j] = mfma16(bf[j], af[i], acc[i][j]);
        }
        asm volatile("s_waitcnt vmcnt(0)" ::: "memory");
        __syncthreads();
    }
}
template <int MT, int NT> DI void zero_acc(f32x4 (&acc)[MT][NT]) {
#pragma unroll
    for (int i = 0; i < MT; ++i)
#pragma unroll
        for (int j = 0; j < NT; ++j) acc[i][j] = (f32x4){0.f, 0.f, 0.f, 0.f};
}

constexpr int INPROJ_NT = 20;
DI void inproj_item(const Params& p, int mt, int nt, unsigned char* smb, int dry) {
    const int m0 = mt * 256, n0 = nt * 256;
    f32x4 acc[8][4]; zero_acc<8, 4>(acc);
    gemm8<8, 4, 4>((const bf16_t*)(p.ws + OFF_H) + (size_t)m0 * 1024, 1024, (const bf16_t*)(p.ws + OFF_KN) + (size_t)n0 * 1024, 1024, 1024, acc, smb);
    const int tid = tid8_(), lane = tid & 63, wave = tid >> 6, wm = wave >> 2, wn = wave & 3, fr = lane & 15, fq = lane >> 4;
    const int cb = n0 + 64 * wn;
    bf16_t* P = (bf16_t*)(p.ws + OFF_P);
    const int rbase = m0 + 128 * wm + fr;
    if (cb >= C_RQ && cb < C_RV) {
        const float sc = cb >= C_RK ? 0.125f : 1.f;
#pragma unroll
        for (int i = 0; i < 8; ++i) {
            const int row = rbase + 16 * i; const float pos = (float)p.pos[row];
#pragma unroll
            for (int j = 0; j < 2; ++j)
#pragma unroll
                for (int jj = 0; jj < 4; ++jj) {
                    const int d = 8 * fq + 4 * j + jj; const float inv = exp2f(-(float)d * (LOG2_1E4 / 32.f));
                    float a = acc[i][j][jj], b = acc[i][j + 2][jj]; rope2(a, b, pos * inv); acc[i][j][jj] = a * sc; acc[i][j + 2][jj] = b * sc;
                }
#pragma unroll
            for (int g = 0; g < 2; ++g) { const u32x2 lo = pk4(acc[i][2 * g]), hi = pk4(acc[i][2 * g + 1]);
                *(u32x4*)(P + (size_t)row * PC + cb + 32 * g + 8 * fq) = (u32x4){lo.x, lo.y, hi.x, hi.y}; }
        }
    } else {
        const bool is_silu = (cb >= C_HG && cb < C_CQ) || (cb >= C_GB && cb < C_RQ) || (cb >= C_RG && cb < C_KR);
        const bool is_hq = cb < C_HZ;
        const bool is_cq = cb >= C_CQ && cb < C_CKV, is_ckv = cb >= C_CKV && cb < C_GB;
#pragma unroll
        for (int i = 0; i < 8; ++i) {
            const int row = rbase + 16 * i;
            if (is_cq || is_ckv) {
                float s = 0.f;
#pragma unroll
                for (int j = 0; j < 4; ++j) s += acc[i][j][0] * acc[i][j][0] + acc[i][j][1] * acc[i][j][1] + acc[i][j][2] * acc[i][j][2] + acc[i][j][3] * acc[i][j][3];
                s += __shfl_xor(s, 16); s += __shfl_xor(s, 32);
                if (fq == 0 && !dry) atomicAdd((float*)(p.ws + OFF_SSQ) + row * 2 + (is_ckv ? 1 : 0), s);
            }
#pragma unroll
            for (int g = 0; g < 2; ++g) {
                f32x4 v0 = acc[i][2 * g], v1 = acc[i][2 * g + 1];
                if (is_silu) {
#pragma unroll
                    for (int jj = 0; jj < 4; ++jj) { v0[jj] = siluf_(v0[jj]); v1[jj] = siluf_(v1[jj]); }
                } else if (is_hq) {
#pragma unroll
                    for (int jj = 0; jj < 4; ++jj) { v0[jj] = siluf_(v0[jj]) * 0.08838834764831845f; v1[jj] = siluf_(v1[jj]) * 0.08838834764831845f; }
                }
                const u32x2 lo = pk4(v0), hi = pk4(v1);
                *(u32x4*)(P + (size_t)row * PC + cb + 32 * g + 8 * fq) = (u32x4){lo.x, lo.y, hi.x, hi.y};
            }
        }
    }
}

DI void kr_item(const Params& p, int item) {
    const int tid = tid8_(), lane = tid & 63, wave = tid >> 6, fr = lane & 15, fq = lane >> 4;
    const int r0 = item * 256 + 32 * wave;
    const bf16_t* ap = (const bf16_t*)(p.ws + OFF_H) + (size_t)(r0 + fr) * 1024 + 8 * fq;
    const bf16_t* bp = (const bf16_t*)(p.ws + OFF_WKR) + (size_t)fr * 1024 + 8 * fq;
    f32x4 acc[2][2];
#pragma unroll
    for (int i = 0; i < 2; ++i)
#pragma unroll
        for (int j = 0; j < 2; ++j) acc[i][j] = (f32x4){0.f, 0.f, 0.f, 0.f};
#pragma unroll 4
    for (int ks = 0; ks < 32; ++ks) {
        const bf16x8 a0 = *(const bf16x8*)(ap + 32 * ks), a1 = *(const bf16x8*)(ap + 16 * 1024 + 32 * ks);
        const bf16x8 b0 = *(const bf16x8*)(bp + 32 * ks), b1 = *(const bf16x8*)(bp + 16 * 1024 + 32 * ks);
        acc[0][0] = mfma16(b0, a0, acc[0][0]); acc[0][1] = mfma16(b1, a0, acc[0][1]);
        acc[1][0] = mfma16(b0, a1, acc[1][0]); acc[1][1] = mfma16(b1, a1, acc[1][1]);
    }
    bf16_t* P = (bf16_t*)(p.ws + OFF_P);
#pragma unroll
    for (int i = 0; i < 2; ++i) {
        const int row = r0 + 16 * i + fr; const float pos = (float)p.pos[row];
#pragma unroll
        for (int jj = 0; jj < 4; ++jj) {
            const int d = 4 * fq + jj; const float inv = exp2f(-(float)d * (LOG2_1E4 / 16.f));
            float a = acc[i][0][jj], b = acc[i][1][jj]; rope2(a, b, pos * inv); acc[i][0][jj] = a; acc[i][1][jj] = b;
        }
#pragma unroll
        for (int j = 0; j < 2; ++j) *(u32x2*)(P + (size_t)row * PC + C_KR + 16 * j + 4 * fq) = pk4(acc[i][j]);
    }
}

DI void kvup_item(const Params& p, int mt, int nt, unsigned char* smb) {
    const int m0 = mt * 256, n0 = nt * 256;
    f32x4 acc[8][4]; zero_acc<8, 4>(acc);
    gemm8<8, 4, 4>((const bf16_t*)(p.ws + OFF_P) + (size_t)m0 * PC + C_CKV, PC, (const bf16_t*)(p.ws + OFF_WUKV) + (size_t)n0 * 256, 256, 256, acc, smb);
    const int tid = tid8_(), lane = tid & 63, wave = tid >> 6, wm = wave >> 2, wn = wave & 3, fr = lane & 15, fq = lane >> 4;
    const int cs = n0 + 64 * wn, head = cs >> 7, isv = (cs >> 6) & 1;
    bf16_t* KN = (bf16_t*)(p.ws + OFF_KN); bf16_t* VT = (bf16_t*)(p.ws + OFF_VT);
    const float* ssq = (const float*)(p.ws + OFF_SSQ);
#pragma unroll
    for (int i = 0; i < 8; ++i) {
        const int row = m0 + 128 * wm + 16 * i + fr;
        const float rstd = rsqrtf(ssq[row * 2 + 1] * (1.f / 256.f) + EPSF);
#pragma unroll
        for (int j = 0; j < 4; ++j) {
            f32x4 v = acc[i][j] * rstd; const int w = 16 * j + 4 * fq;
            if (!isv) *(u32x2*)(KN + (size_t)row * 512 + head * 64 + w) = pk4(v);
            else { const int b = row >> 13, t = row & 8191;
#pragma unroll
                for (int jj = 0; jj < 4; ++jj) VT[((size_t)((b * 8 + head) * 64 + w + jj)) * SEQ + t] = f2bf(v[jj]); }
        }
    }
}

DI void qup_item(const Params& p, int item, bf16_t* sm, int dry) {
    const int m0 = item * 64, tid = tid8_(), lane = tid & 63, wave = tid >> 6, fr = lane & 15, fq = lane >> 4;
    bf16_t* P = (bf16_t*)(p.ws + OFF_P);
    constexpr int AP = 776;
#pragma unroll
    for (int i = 0; i < 12; ++i) { const int c = tid + 512 * i, r = c / 96, cc = c % 96;
        *(u32x4*)(sm + r * AP + cc * 8) = *(const u32x4*)(P + (size_t)(m0 + r) * PC + C_CQ + cc * 8); }
    __syncthreads();
    const bf16_t* W = (const bf16_t*)(p.ws + OFF_WUQ);
    const int nc0 = 96 * wave;
    f32x4 acc[4][6];
#pragma unroll
    for (int i = 0; i < 4; ++i)
#pragma unroll
        for (int j = 0; j < 6; ++j) acc[i][j] = (f32x4){0.f, 0.f, 0.f, 0.f};
    const bf16_t* wp = W + (size_t)(nc0 >> 4) * 24 * 512 + lane * 8;
    bf16x8 bq[3][6];
#pragma unroll
    for (int u = 0; u < 3; ++u)
#pragma unroll
        for (int j = 0; j < 6; ++j) bq[u][j] = *(const bf16x8*)(wp + (size_t)(j * 24 + u) * 512);
#pragma unroll 1
    for (int ks0 = 0; ks0 < 24; ks0 += 3) {
#pragma unroll
        for (int u = 0; u < 3; ++u) {
            const int ks = ks0 + u;
            bf16x8 af[4];
#pragma unroll
            for (int i = 0; i < 4; ++i) af[i] = *(const bf16x8*)(sm + (16 * i + fr) * AP + 32 * ks + 8 * fq);
#pragma unroll
            for (int j = 0; j < 6; ++j) {
#pragma unroll
                for (int i = 0; i < 4; ++i) acc[i][j] = mfma16(bq[u][j], af[i], acc[i][j]);
            }
            if (ks + 3 < 24) {
#pragma unroll
                for (int j = 0; j < 6; ++j) bq[u][j] = *(const bf16x8*)(wp + (size_t)(j * 24 + ks + 3) * 512);
            }
        }
    }
    const float* ssq = (const float*)(p.ws + OFF_SSQ);
#pragma unroll
    for (int i = 0; i < 4; ++i) {
        const int row = m0 + 16 * i + fr; const float rstd = rsqrtf(ssq[row * 2] * (1.f / 768.f) + EPSF); const float pos = (float)p.pos[row];
#pragma unroll
        for (int j = 0; j < 6; j += 2) {
            f32x4 a = acc[i][j] * rstd, b = acc[i][j + 1] * rstd; const int col = nc0 + 16 * j;
            if (col >= 512) {
#pragma unroll
                for (int jj = 0; jj < 4; ++jj) { const int d = 4 * fq + jj; const float inv = exp2f(-(float)d * (LOG2_1E4 / 16.f)); float x1 = a[jj], x2 = b[jj]; rope2(x1, x2, pos * inv); a[jj] = x1; b[jj] = x2; }
            }
            if (!dry) { *(u32x2*)(P + (size_t)row * PC + C_CQ + col + 4 * fq) = pk4(a);
            *(u32x2*)(P + (size_t)row * PC + C_CQ + col + 16 + 4 * fq) = pk4(b); }
        }
    }
    __syncthreads();
}

DI void attn_item(const Params& p, int qt, int bh, bf16_t* sm, int dry) {
    const int b = bh >> 3, h = bh & 7;
    const int tid = tid8_(), lane = tid & 63, wave = tid >> 6, ql = lane & 31, hh = lane >> 5;
    const int q0 = qt * 256, tokbase = b * SEQ;
    bf16_t* P = (bf16_t*)(p.ws + OFF_P);
    const bf16_t* KN = (const bf16_t*)(p.ws + OFF_KN); const bf16_t* VT = (const bf16_t*)(p.ws + OFF_VT) + (size_t)((b * 8 + h) * 64) * SEQ;
    const int qrow = tokbase + q0 + 32 * wave + ql;
    bf16x8 qf[6];
    { const bf16_t* qp = P + (size_t)qrow * PC + C_CQ;
#pragma unroll
      for (int ks = 0; ks < 4; ++ks) qf[ks] = *(const bf16x8*)(qp + h * 64 + 16 * ks + 8 * hh);
#pragma unroll
      for (int ks = 0; ks < 2; ++ks) qf[4 + ks] = *(const bf16x8*)(qp + 512 + h * 32 + 16 * ks + 8 * hh); }
    constexpr int KP = 104, VP = 136, KSZ = 128 * KP, VSZ = 64 * VP;
    bf16_t* Ks = sm; bf16_t* Vs = sm + 2 * KSZ;
    f32x16 o[2];
#pragma unroll
    for (int i = 0; i < 16; ++i) { o[0][i] = 0.f; o[1][i] = 0.f; }
    float mrun = 0.f, lsum = 0.f;
    const int nkt = 2 * qt + 2;
    const int qg = q0 + 32 * wave + ql;
    u32x4 rk[3], rv[2];
    auto gload = [&](int kt) {
        const int k0 = tokbase + kt * 128;
#pragma unroll
        for (int i = 0; i < 3; ++i) {
            const int c = tid + 512 * i, key = c / 12, cc = c % 12, tok = k0 + key;
            rk[i] = *(const u32x4*)(cc < 8 ? KN + (size_t)tok * 512 + h * 64 + cc * 8 : P + (size_t)tok * PC + C_KR + (cc - 8) * 8);
        }
#pragma unroll
        for (int i = 0; i < 2; ++i) { const int c = tid + 512 * i; rv[i] = *(const u32x4*)(VT + (size_t)(c >> 4) * SEQ + kt * 128 + (c & 15) * 8); }
    };
    gload(0);
#pragma unroll 1
    for (int kt = 0; kt < nkt; ++kt) {
        const int buf = kt & 1;
        bf16_t* Kb = Ks + buf * KSZ; bf16_t* Vb = Vs + buf * VSZ;
#pragma unroll
        for (int i = 0; i < 3; ++i) { const int c = tid + 512 * i; *(u32x4*)(Kb + (c / 12) * KP + (c % 12) * 8) = rk[i]; }
#pragma unroll
        for (int i = 0; i < 2; ++i) { const int c = tid + 512 * i; *(u32x4*)(Vb + (c >> 4) * VP + (c & 15) * 8) = rv[i]; }
        __syncthreads();
        if (kt + 1 < nkt) gload(kt + 1);
        f32x16 s[4];
        __builtin_amdgcn_s_setprio(1);
        {
#pragma unroll
            for (int sub = 0; sub < 4; ++sub)
#pragma unroll
                for (int i = 0; i < 16; ++i) s[sub][i] = -mrun;
#pragma unroll
            for (int sub = 0; sub < 4; ++sub)
#pragma unroll
                for (int ks = 0; ks < 6; ++ks) {
                    const bf16x8 kf = *(const bf16x8*)(Kb + (32 * sub + ql) * KP + 16 * ks + 8 * hh);
                    s[sub] = mfma32(kf, qf[ks], s[sub]);
                }
            __builtin_amdgcn_sched_group_barrier(0x100, 8, 0);
#pragma unroll
            for (int u = 0; u < 16; ++u) { __builtin_amdgcn_sched_group_barrier(0x008, 1, 0); __builtin_amdgcn_sched_group_barrier(0x100, 1, 0); }
            __builtin_amdgcn_sched_group_barrier(0x008, 8, 0);
        }
        __builtin_amdgcn_s_setprio(0);
        if (kt >= nkt - 2) {
#pragma unroll
            for (int sub = 0; sub < 4; ++sub)
#pragma unroll
                for (int i = 0; i < 16; ++i) { const int kg = kt * 128 + 32 * sub + crow(i, hh); if (kg > qg) s[sub][i] = -1e30f; }
        }
        float mx = s[0][0];
#pragma unroll
        for (int sub = 0; sub < 4; ++sub)
#pragma unroll
            for (int i = 0; i < 16; ++i) mx = fmaxf(mx, s[sub][i]);
        mx = fmaxf(mx, __shfl_xor(mx, 32));
        if (__builtin_amdgcn_ballot_w64(mx > 0.f) != 0) {
            const float delta = fmaxf(mx, 0.f), alpha = __builtin_amdgcn_exp2f(-delta);
            mrun += delta; lsum *= alpha;
#pragma unroll
            for (int i = 0; i < 16; ++i) { s[0][i] -= delta; s[1][i] -= delta; s[2][i] -= delta; s[3][i] -= delta; o[0][i] *= alpha; o[1][i] *= alpha; }
        }
        f32x2 rs2 = {0.f, 0.f};
#pragma unroll
        for (int sub = 0; sub < 4; ++sub)
#pragma unroll
            for (int i = 0; i < 16; i += 2) {
                s[sub][i] = __builtin_amdgcn_exp2f(s[sub][i]); s[sub][i + 1] = __builtin_amdgcn_exp2f(s[sub][i + 1]);
                rs2 += (f32x2){s[sub][i], s[sub][i + 1]};
            }
        lsum += rs2[0] + rs2[1];
#pragma unroll
        for (int sub = 0; sub < 4; ++sub)
#pragma unroll
            for (int s2 = 0; s2 < 2; ++s2) {
                const bf16x8 pf = pack8(s[sub][8 * s2], s[sub][8 * s2 + 1], s[sub][8 * s2 + 2], s[sub][8 * s2 + 3], s[sub][8 * s2 + 4], s[sub][8 * s2 + 5], s[sub][8 * s2 + 6], s[sub][8 * s2 + 7]);
#pragma unroll
                for (int dt = 0; dt < 2; ++dt) {
                    const bf16_t* vp = Vb + (32 * dt + ql) * VP + 32 * sub + 16 * s2 + 4 * hh;
                    const bf16x8 vf = join8(*(const u32x2*)vp, *(const u32x2*)(vp + 8));
                    o[dt] = mfma32(vf, pf, o[dt]);
                }
            }
        __builtin_amdgcn_sched_group_barrier(0x100, 4, 1);
#pragma unroll
        for (int u = 0; u < 12; ++u) { __builtin_amdgcn_sched_group_barrier(0x008, 1, 1); __builtin_amdgcn_sched_group_barrier(0x100, 1, 1); }
        __builtin_amdgcn_sched_group_barrier(0x008, 4, 1);
    }
    lsum += __shfl_xor(lsum, 32);
    const float inv = 1.f / lsum;
    bf16_t* gp = P + (size_t)qrow * PC + C_GB + h * 64;
#pragma unroll
    for (int dt = 0; dt < 2; ++dt)
#pragma unroll
        for (int g = 0; g < 4; ++g) {
            const int dv = 32 * dt + 8 * g + 4 * hh;
            const f32x4 gate = unpk4(*(const u32x2*)(gp + dv));
            f32x4 y;
#pragma unroll
            for (int jj = 0; jj < 4; ++jj) y[jj] = o[dt][4 * g + jj] * inv * gate[jj];
            if (!dry) *(u32x2*)(gp + dv) = pk4(y);
        }
    __syncthreads();
}

template <int DK, bool RET, bool OUT>
DI void gla_item(const Params& p, int l, int item, unsigned char* smraw, int dry) {
    constexpr int NT = DK / 32, NP = 256 / DK, TP = 32 / NP, PQ = DK + 8, PT = 40;
    const int b = item >> 6, h = (item >> 4) & 3, seg = item & 15;
    const int tid = tid_(), lane = tid & 63, wave = tid >> 6, ql = lane & 31, hh = lane >> 5;
    bf16_t* Qt = (bf16_t*)smraw; bf16_t* Qh = Qt + 32 * PQ; bf16_t* Kt = Qh + 32 * PQ; bf16_t* KhT = Kt + 32 * PQ; bf16_t* VTs = KhT + DK * PT;
    float* tots = (float*)(VTs + 128 * PT); float* decs = tots + NP * DK; float* sums = decs + DK;
    bf16_t* P = (bf16_t*)(p.ws + OFF_P);
    const int tok0 = b * SEQ + seg * 512;
    const int qcol = RET ? C_RQ + h * 64 : C_HQ + h * 128, kcol = RET ? C_RK + h * 64 : C_HZ + h * 128;
    const int vcol = (RET ? C_RV : C_HV) + h * 128, gcol = (RET ? C_RG : C_HG) + h * 128;
    float* U = (float*)(p.ws + (RET ? OFF_RTU : OFF_HGU)); constexpr int USZ = DK * 128;
    float* HB = (float*)(p.ws + OFF_HGB);
    const float lgam = log1pf(-exp2f(-5.f - (float)h));
    f32x16 S[NT];
#pragma unroll
    for (int t = 0; t < NT; ++t)
#pragma unroll
        for (int i = 0; i < 16; ++i) S[t][i] = 0.f;
    if (OUT) {
        float* dall = (float*)smraw;
        if (!RET) {
            for (int e = tid; e < seg * 128; e += 256) dall[e] = __expf(HB[(item - seg) * 128 + e]);
            __syncthreads();
        }
        const float rdec = __expf(512.f * lgam);
#pragma unroll 2
        for (int m = 0; m < seg; ++m) {
            const int it2 = item - seg + m;
#pragma unroll
            for (int t = 0; t < NT; ++t)
#pragma unroll
                for (int i = 0; i < 16; ++i) {
                    const float dec = RET ? rdec : dall[m * 128 + 32 * t + crow(i, hh)];
                    S[t][i] = S[t][i] * dec + U[(size_t)it2 * USZ + (t * 16 + i) * 256 + tid];
                }
        }
    }
    const int d = tid % DK, part = tid / DK;
    const float lbv = RET ? 0.f : ((const float*)(p.ws + OFF_LB))[l * 512 + h * 128 + d];
    float btot_run = 0.f;
    const int vdv = tid & 127, vhalf = tid >> 7;
    unsigned rq[TP], rz[TP], rv[16];
    auto prefetch = [&](int ch) {
        const int t0 = tok0 + ch * 32;
#pragma unroll
        for (int t = 0; t < TP; ++t) {
            const bf16_t* row = P + (size_t)(t0 + part * TP + t) * PC;
            if (OUT) rq[t] = row[qcol + d];
            rz[t] = row[kcol + d];
        }
#pragma unroll
        for (int t = 0; t < 16; ++t) rv[t] = P[(size_t)(t0 + vhalf * 16 + t) * PC + vcol + vdv];
    };
    prefetch(0);
#pragma unroll 1
    for (int ch = 0; ch < 16; ++ch) {
        const int t0 = tok0 + ch * 32;
        float run = 0.f;
        float lfv[TP], kvs[TP];
#pragma unroll
        for (int t = 0; t < TP; ++t) {
            const float z = __uint_as_float(rz[t] << 16);
            if (RET) { kvs[t] = z; lfv[t] = lgam; }
            else {
                const float sg = __builtin_amdgcn_rcpf(1.f + __builtin_amdgcn_exp2f(-1.4426950408889634f * z));
                lfv[t] = __logf(fmaxf(lbv + (1.f - lbv) * sg, 1e-20f));
                kvs[t] = (1.f - lbv) * (1.f - sg);
            }
            run += lfv[t];
        }
        tots[part * DK + d] = run;
        *(u32x4*)(VTs + vdv * PT + vhalf * 16) = (u32x4){rv[0] | (rv[1] << 16), rv[2] | (rv[3] << 16), rv[4] | (rv[5] << 16), rv[6] | (rv[7] << 16)};
        *(u32x4*)(VTs + vdv * PT + vhalf * 16 + 8) = (u32x4){rv[8] | (rv[9] << 16), rv[10] | (rv[11] << 16), rv[12] | (rv[13] << 16), rv[14] | (rv[15] << 16)};
        __syncthreads();
        float base = 0.f, rref = 0.f, blast = 0.f;
#pragma unroll
        for (int pp = 0; pp < NP; ++pp) { const float tt = tots[pp * DK + d]; if (pp < part) base += tt; if (pp < NP / 2) rref += tt; blast += tt; }
        unsigned khp[TP / 2];
        float bt = base;
        const float er = __expf(rref), ebr = __expf(blast - rref);
#pragma unroll
        for (int t = 0; t < TP; ++t) {
            const float kvv = kvs[t];
            bt += lfv[t];
            const int tr = part * TP + t;
            unsigned khb;
            if (OUT) {
                const float qv = __uint_as_float(rq[t] << 16);
                const float e1 = __expf(bt - rref), e2 = __builtin_amdgcn_rcpf(e1);
                Qt[tr * PQ + d] = f2bf(qv * e1);
                Qh[tr * PQ + d] = f2bf(qv * e1 * er);
                Kt[tr * PQ + d] = f2bf(kvv * e2);
                khb = f2bf(kvv * e2 * ebr);
            } else {
                khb = f2bf(kvv * __expf(blast - bt));
            }
            if (t & 1) khp[t >> 1] |= khb << 16; else khp[t >> 1] = khb;
        }
        *(u32x4*)(KhT + d * PT + part * TP) = (u32x4){khp[0], khp[1], khp[2], khp[3]};
        if (TP == 16) *(u32x4*)(KhT + d * PT + part * TP + 8) = (u32x4){khp[TP / 2 - 4], khp[TP / 2 - 3], khp[TP / 2 - 2], khp[TP / 2 - 1]};
        if (part == 0) { decs[d] = __expf(blast); btot_run += blast; }
        if (ch + 1 < 16) prefetch(ch + 1);
        __syncthreads();
        f32x16 o;
        u32x2 gate_r[4];
        if (OUT) {
#pragma unroll
            for (int g = 0; g < 4; ++g) gate_r[g] = *(const u32x2*)(P + (size_t)(t0 + ql) * PC + gcol + 32 * wave + 8 * g + 4 * hh);
        }
        if (OUT) {
            f32x16 at;
#pragma unroll
            for (int i = 0; i < 16; ++i) { at[i] = 0.f; o[i] = 0.f; }
#pragma unroll
            for (int ks = 0; ks < DK / 16; ++ks) {
                const bf16x8 kf = *(const bf16x8*)(Kt + ql * PQ + 16 * ks + 8 * hh);
                const bf16x8 qf = *(const bf16x8*)(Qt + ql * PQ + 16 * ks + 8 * hh);
                at = mfma32(kf, qf, at);
            }
#pragma unroll
            for (int i = 0; i < 16; ++i) if (crow(i, hh) > ql) at[i] = 0.f;
#pragma unroll
            for (int s2 = 0; s2 < 2; ++s2) {
                const bf16x8 pa = pack8(at[8 * s2], at[8 * s2 + 1], at[8 * s2 + 2], at[8 * s2 + 3], at[8 * s2 + 4], at[8 * s2 + 5], at[8 * s2 + 6], at[8 * s2 + 7]);
                const bf16_t* vp = VTs + (32 * wave + ql) * PT + 16 * s2 + 4 * hh;
                o = mfma32(join8(*(const u32x2*)vp, *(const u32x2*)(vp + 8)), pa, o);
            }
#pragma unroll
            for (int t = 0; t < NT; ++t)
#pragma unroll
                for (int s2 = 0; s2 < 2; ++s2) {
                    const bf16x8 sf = pack8(S[t][8 * s2], S[t][8 * s2 + 1], S[t][8 * s2 + 2], S[t][8 * s2 + 3], S[t][8 * s2 + 4], S[t][8 * s2 + 5], S[t][8 * s2 + 6], S[t][8 * s2 + 7]);
                    const bf16_t* qp = Qh + ql * PQ + 32 * t + 16 * s2 + 4 * hh;
                    o = mfma32(sf, join8(*(const u32x2*)qp, *(const u32x2*)(qp + 8)), o);
                }
        }
#pragma unroll
        for (int t = 0; t < NT; ++t) {
#pragma unroll
            for (int i = 0; i < 16; ++i) S[t][i] *= decs[32 * t + crow(i, hh)];
#pragma unroll
            for (int s2 = 0; s2 < 2; ++s2) {
                const bf16x8 kf = *(const bf16x8*)(KhT + (32 * t + ql) * PT + 16 * s2 + 8 * hh);
                const bf16x8 vf = *(const bf16x8*)(VTs + (32 * wave + ql) * PT + 16 * s2 + 8 * hh);
                S[t] = mfma32(kf, vf, S[t]);
            }
        }
        if (OUT) {
            float ss = 0.f;
#pragma unroll
            for (int i = 0; i < 16; ++i) ss += o[i] * o[i];
            ss += __shfl_xor(ss, 32);
            if (hh == 0) sums[wave * 32 + ql] = ss;
            __syncthreads();
            const float tot = sums[ql] + sums[32 + ql] + sums[64 + ql] + sums[96 + ql];
            const float rstd = rsqrtf(tot * (1.f / 128.f) + EPSF);
            bf16_t* gp = P + (size_t)(t0 + ql) * PC + gcol;
#pragma unroll
            for (int g = 0; g < 4; ++g) {
                const int dv = 32 * wave + 8 * g + 4 * hh;
                const f32x4 gate = unpk4(gate_r[g]);
                f32x4 y;
#pragma unroll
                for (int jj = 0; jj < 4; ++jj) { const float gn = RET ? 1.f : p.hg_onorm[l * 128 + dv + jj]; y[jj] = o[4 * g + jj] * rstd * gn * gate[jj]; }
                if (!dry) *(u32x2*)(gp + dv) = pk4(y);
            }
        } else {
            __syncthreads();
        }
    }
    if (!OUT) {
#pragma unroll
        for (int t = 0; t < NT; ++t)
#pragma unroll
            for (int i = 0; i < 16; ++i) U[(size_t)item * USZ + (t * 16 + i) * 256 + tid] = S[t][i];
        if (!RET && part == 0) HB[item * 128 + d] = btot_run;
    }
    __syncthreads();
}

DI void merge_item(const Params& p, int mt, int nt, unsigned char* smb) {
    const int m0 = mt * 256, n0 = nt * 128;
    f32x4 am[4][4]; zero_acc<4, 4>(am);
    const bf16_t* H = (const bf16_t*)(p.ws + OFF_H) + (size_t)m0 * 1024;
    bf16_t* P = (bf16_t*)(p.ws + OFF_P);
#pragma unroll 1
    for (int br = 0; br < 3; ++br) {
        const int ycol = br == 0 ? C_HG : (br == 1 ? C_GB : C_RG);
        u32x2 sg[4][4];
        { f32x4 ag[4][4]; zero_acc<4, 4>(ag);
          gemm8<4, 4, 2>(H, 1024, (const bf16_t*)(p.ws + OFF_WM) + (size_t)(br * 1024 + n0) * 1024, 1024, 1024, ag, smb);
#pragma unroll
          for (int i = 0; i < 4; ++i)
#pragma unroll
              for (int j = 0; j < 4; ++j) { f32x4 g;
#pragma unroll
                  for (int jj = 0; jj < 4; ++jj) g[jj] = sigmoidf_(ag[i][j][jj]);
                  sg[i][j] = pk4(g); } }
        f32x4 ay[4][4]; zero_acc<4, 4>(ay);
        gemm8<4, 4, 2>(P + (size_t)m0 * PC + ycol, PC, (const bf16_t*)(p.ws + OFF_WP) + (size_t)br * 1024 * 512 + (size_t)n0 * 512, 512, 512, ay, smb);
#pragma unroll
        for (int i = 0; i < 4; ++i)
#pragma unroll
            for (int j = 0; j < 4; ++j) { const f32x4 g = unpk4(sg[i][j]);
#pragma unroll
                for (int jj = 0; jj < 4; ++jj) am[i][j][jj] += g[jj] * ay[i][j][jj]; }
    }
    const int tid = tid8_(), lane = tid & 63, wave = tid >> 6, wm = wave >> 1, wn = wave & 1, fr = lane & 15, fq = lane >> 4;
#pragma unroll
    for (int i = 0; i < 4; ++i) {
        const int row = m0 + 64 * wm + 16 * i + fr;
#pragma unroll
        for (int j = 0; j < 4; ++j) *(u32x2*)(P + (size_t)row * PC + n0 + 64 * wn + 16 * j + 4 * fq) = pk4(am[i][j]);
    }
}

DI void out_item(const Params& p, int l, int mt, int nt, unsigned char* smb, int dry) {
    const int m0 = mt * 256, n0 = nt * 256;
    f32x4 acc[8][4]; zero_acc<8, 4>(acc);
    gemm8<8, 4, 4>((const bf16_t*)(p.ws + OFF_P) + (size_t)m0 * PC, PC, (const bf16_t*)(p.ws + OFF_WOUT) + (size_t)n0 * 1024, 1024, 1024, acc, smb);
    const int tid = tid8_(), lane = tid & 63, wave = tid >> 6, wm = wave >> 2, wn = wave & 3, fr = lane & 15, fq = lane >> 4;
    const float* xin = l == 0 ? p.x : p.out;
#pragma unroll
    for (int i = 0; i < 8; ++i) {
        const int row = m0 + 128 * wm + 16 * i + fr, b = row >> 13;
        const float* gate = (const float*)(p.ws + OFF_MOD) + (l * 2 + b) * 3072 + 2048;
#pragma unroll
        for (int j = 0; j < 4; ++j) {
            const int col = n0 + 64 * wn + 16 * j + 4 * fq;
            const f32x4 xo = *(const f32x4*)(xin + (size_t)row * 1024 + col), g = *(const f32x4*)(gate + col);
            f32x4 r;
#pragma unroll
            for (int jj = 0; jj < 4; ++jj) r[jj] = xo[jj] + g[jj] * acc[i][j][jj];
            if (!dry) *(f32x4*)(p.out + (size_t)row * 1024 + col) = r;
        }
    }
}

constexpr int LDS_BYTES = 131072, HALF_LDS = 65536;
constexpr int N_PHASES = 14;
DI void phase_prep(const Params& p, unsigned char* sm) {
    const int bid = blockIdx.x, G = gridDim.x, vb = vb_();
    unsigned char* smv = sm + vb * HALF_LDS;
    if (bid == 0) { const int t = tid8_(); if (t < 256) ((unsigned*)p.ws)[t] = 0u; }
    if (bid == G - 1 && vb == 1) lb_item(p);
#pragma unroll 1
    for (int k = bid; k < 96; k += G) mod_item(p, 2 * k + vb, (float*)smv);
}
DI void phase_final(const Params& p) { for (int it = 2 * blockIdx.x + vb_(); it < 4096; it += 2 * gridDim.x) final_item(p, it); }
template <int SP> DI void layer_phase(const Params& p, int l, unsigned char* sm, int dry, int qidx) {
    const int bid = blockIdx.x, G = gridDim.x, vb = vb_();
    unsigned char* smv = sm + vb * HALF_LDS;
    if (SP == 0) {
#pragma unroll 1
        for (int it = 2 * bid + vb; it < 4096; it += 2 * G) norm_item(p, l, it);
#pragma unroll 1
        for (int k = G - 1 - bid; k < CONV_ITEMS / 2; k += G) conv_weights(p, l, 2 * k + vb, (float*)smv);
    } else if (SP == 1) {
#pragma unroll 1
        for (int q = bid >> 3; q < 8 * INPROJ_NT; q += (G >> 3)) inproj_item(p, 8 * (bid & 7) + (q & 7), q >> 3, sm, dry);
    } else if (SP == 2) {
        const int xcd = bid & 7, nq = G >> 3;
        unsigned* ctr = (unsigned*)p.ws + qidx + xcd * 2;
        int it = bid >> 3;
#pragma unroll 1
        for (;;) {
            if (it >= 88) break;
            if (it < 8) { for (int r = 0; r < REPG2; ++r) gla_item<128, false, false>(p, l, 2 * (xcd * 8 + it) + vb, smv, dry); }
            else if (it < 16) { for (int r = 0; r < REPG2; ++r) gla_item<64, true, false>(p, l, 2 * (xcd * 8 + it - 8) + vb, smv, dry); }
            else if (it < 24) kr_item(p, xcd * 8 + it - 16);
            else if (it < 56) { for (int r = 0; r < REPQ2; ++r) qup_item(p, xcd * 32 + it - 24, (bf16_t*)sm, dry | (r + 1 < REPQ2)); }
            else { const int t = xcd * 32 + it - 56; for (int r = 0; r < REPK2; ++r) kvup_item(p, t >> 2, t & 3, sm); }
            it = nq + grab_item(ctr, sm);
        }
    } else if (SP == 3) {
        const int xcd = bid & 7;
        unsigned* ctr = (unsigned*)p.ws + qidx + xcd * 2;
        int it = bid >> 3;
#pragma unroll 1
        for (;; it = (G >> 3) + grab_item(ctr, sm)) {
            if (it >= 80) break;
            if (it < 8) { for (int r = 0; r < REPG3; ++r) gla_item<128, false, true>(p, l, 2 * (xcd * 8 + it) + vb, smv, dry | (r + 1 < REPG3)); }
            else if (it < 16) { for (int r = 0; r < REPG3; ++r) gla_item<64, true, true>(p, l, 2 * (xcd * 8 + it - 8) + vb, smv, dry | (r + 1 < REPG3)); }
            else { for (int r = 0; r < REPA3; ++r) attn_item(p, 31 - ((it - 16) >> 1), 2 * xcd + ((it - 16) & 1), (bf16_t*)sm, dry | (r + 1 < REPA3)); }
        }
    } else if (SP == 4) {
#pragma unroll 1
        for (int q = bid >> 3; q < 8 * 8; q += (G >> 3)) merge_item(p, 8 * (bid & 7) + (q & 7), q >> 3, sm);
    } else {
#pragma unroll 1
        for (int q = bid >> 3; q < 8 * 4; q += (G >> 3)) out_item(p, l, 8 * (bid & 7) + (q & 7), q >> 3, sm, dry);
    }
}

#if ONE_LAUNCH
__global__ void __launch_bounds__(512, 2) __attribute__((amdgpu_waves_per_eu(2, 2))) fwd_megakernel(Params p) {
    extern __shared__ __attribute__((aligned(1024))) unsigned char sm[];
    cg::grid_group grid = cg::this_grid();
    unsigned* gbar = (unsigned*)(p.ws + OFF_BAR); unsigned gk = 0;
    phase_prep(p, sm); grid.sync();
#define RUN_PH(SP, L, REP) for (int rep = 0; rep < (REP); ++rep) { int dry = (rep + 1 < (REP)) ? 1 : 0; asm volatile("" : "+s"(dry)); layer_phase<SP>(p, L, sm, dry, (L) * 128 + (SP) * 16 + rep); grid_barrier(gbar, ++gk); }
    RUN_PH(0, 0, REP0) RUN_PH(1, 0, REP1) RUN_PH(2, 0, REP2) RUN_PH(3, 0, REP3) RUN_PH(4, 0, REP4) RUN_PH(5, 0, REP5)
    RUN_PH(0, 1, REP0) RUN_PH(1, 1, REP1) RUN_PH(2, 1, REP2) RUN_PH(3, 1, REP3) RUN_PH(4, 1, REP4) RUN_PH(5, 1, REP5)
    phase_final(p);
}
#else
__global__ void __launch_bounds__(512, 2) phase_kernel(Params p, int ph) {
    extern __shared__ __attribute__((aligned(1024))) unsigned char sm[];
    if (ph == 0) { phase_prep(p, sm); return; }
    if (ph == 13) { phase_final(p); return; }
    const int l = (ph - 1) / 6, sp = (ph - 1) % 6;
    if (sp == 0) layer_phase<0>(p, l, sm, 0, l * 128 + 0 * 16); else if (sp == 1) layer_phase<1>(p, l, sm, 0, l * 128 + 1 * 16); else if (sp == 2) layer_phase<2>(p, l, sm, 0, l * 128 + 2 * 16);
    else if (sp == 3) layer_phase<3>(p, l, sm, 0, l * 128 + 3 * 16); else if (sp == 4) layer_phase<4>(p, l, sm, 0, l * 128 + 4 * 16); else layer_phase<5>(p, l, sm, 0, l * 128 + 5 * 16);
}
#endif

extern "C" void kernel_launch(void* const* d_in, const int* in_sizes, int n_in, void* d_out, int out_size, void* d_ws, size_t ws_size, hipStream_t stream) {
    Params p{};
    p.x = (const float*)d_in[0]; p.c = (const float*)d_in[1]; p.pos = (const int*)d_in[2]; p.norm_g = (const float*)d_in[3];
    p.w_mod = (const float*)d_in[4]; p.b_mod = (const float*)d_in[5]; p.w_in = (const float*)d_in[6]; p.hg_lb = (const float*)d_in[7];
    p.hg_onorm = (const float*)d_in[8]; p.g_cq = (const float*)d_in[9]; p.w_uq = (const float*)d_in[10]; p.g_ckv = (const float*)d_in[11];
    p.w_ukv = (const float*)d_in[12]; p.w_pa = (const float*)d_in[13]; p.w_pb = (const float*)d_in[14]; p.w_pc = (const float*)d_in[15];
    p.w_out = (const float*)d_in[16]; p.final_g = (const float*)d_in[17];
    p.out = (float*)d_out; p.ws = (unsigned char*)d_ws;
#if ONE_LAUNCH
    static int grid_blocks = 0;
    if (!grid_blocks) {
        int dev = 0, cus = 0, per_cu = 0;
        (void)hipGetDevice(&dev);
        (void)hipDeviceGetAttribute(&cus, hipDeviceAttributeMultiprocessorCount, dev);
        if (hipFuncSetAttribute((const void*)fwd_megakernel, hipFuncAttributeMaxDynamicSharedMemorySize, LDS_BYTES) != hipSuccess)
            fprintf(stderr, "hipFuncSetAttribute(MaxDynamicSharedMemorySize=%d) failed\n", LDS_BYTES);
        (void)hipOccupancyMaxActiveBlocksPerMultiprocessor(&per_cu, fwd_megakernel, 512, LDS_BYTES);
        if (per_cu < 1) per_cu = 1;
        if (per_cu > 1) per_cu = 1;
        grid_blocks = (cus / 8) * 8 * per_cu;
    }
    (void)hipMemsetAsync((unsigned char*)d_ws + OFF_BAR, 0, BAR_BYTES, stream);
    void* args[] = {&p};
    hipError_t e = hipLaunchCooperativeKernel((void*)fwd_megakernel, dim3(grid_blocks), dim3(512), args, LDS_BYTES, stream);
    if (e != hipSuccess) fprintf(stderr, "cooperative launch failed: %s (grid %d)\n", hipGetErrorString(e), grid_blocks);
#else
    (void)hipFuncSetAttribute((const void*)phase_kernel, hipFuncAttributeMaxDynamicSharedMemorySize, LDS_BYTES);
    for (int ph = 0; ph < N_PHASES; ++ph) phase_kernel<<<256, 512, LDS_BYTES, stream>>>(p, ph);
#endif
}
```

```cpp
#include <hip/hip_runtime.h>
#include <hip/hip_cooperative_groups.h>
#include <cstdio>
#include <cstdint>
namespace cg = cooperative_groups;

#define DI __device__ __forceinline__
typedef unsigned short bf16_t;
typedef short bf16x8 __attribute__((ext_vector_type(8)));
typedef float f32x4 __attribute__((ext_vector_type(4)));
typedef float f32x16 __attribute__((ext_vector_type(16)));
typedef float f32x2 __attribute__((ext_vector_type(2)));
typedef unsigned u32x2 __attribute__((ext_vector_type(2)));
typedef unsigned u32x4 __attribute__((ext_vector_type(4)));
typedef __bf16 bf16x2_t __attribute__((ext_vector_type(2)));

#ifndef ONE_LAUNCH
#define ONE_LAUNCH 1
#endif
#define REP0 1
#define REP1 1
#define REP2 1
#define REP3 1
#define REP4 1
#define REP5 1
#define REPG3 1
#define REPA3 1
#define REPG2 1
#define REPQ2 1
#define REPK2 1

constexpr int SEQ = 8192, NTOK = 16384, DM = 1024;
constexpr int PC = 5152;
constexpr int DIN = 8224;
constexpr int C_HQ = 0, C_HZ = 512, C_HV = 1024, C_HG = 1536, C_CQ = 2048, C_CKV = 2816, C_GB = 3072,
              C_RQ = 3584, C_RK = 3840, C_RV = 4096, C_RG = 4608, C_KR = 5120;
constexpr float EPSF = 1e-6f;
constexpr float LOG2_1E4 = 13.287712379549449f;
constexpr float QSCALE = 0.10206207261596577f * 1.4426950408889634f;

constexpr size_t OFF_MOD = 4096;
constexpr size_t OFF_LB  = OFF_MOD + 2 * 2 * 3072 * 4;
constexpr size_t OFF_SSQ = OFF_LB + 2 * 512 * 4;
constexpr size_t OFF_HGB = OFF_SSQ + 16384 * 2 * 4;
constexpr size_t OFF_HGU = 262144;
constexpr size_t OFF_RTU = OFF_HGU + 128ull * 16384 * 4;
constexpr size_t OFF_WM  = OFF_RTU + 128ull * 8192 * 4;
constexpr size_t OFF_WUQ = OFF_WM + 3072ull * 1024 * 2;
constexpr size_t OFF_WUKV = OFF_WUQ + 768ull * 768 * 2;
constexpr size_t OFF_WP  = OFF_WUKV + 1024ull * 256 * 2;
constexpr size_t OFF_WOUT = OFF_WP + 3ull * 1024 * 512 * 2;
constexpr size_t OFF_H   = OFF_WOUT + 1024ull * 1024 * 2;
constexpr size_t OFF_P   = OFF_H + 16384ull * 1024 * 2;
constexpr size_t OFF_KN  = OFF_P + 16384ull * PC * 2;
constexpr size_t OFF_VT  = OFF_KN + 16384ull * 512 * 2;
constexpr size_t OFF_WKR = OFF_VT + 16384ull * 512 * 2;
constexpr size_t OFF_BAR = OFF_WKR + 32ull * 1024 * 2;
constexpr size_t BAR_BYTES = 8192;
constexpr size_t WS_END  = OFF_BAR + BAR_BYTES;
static_assert(OFF_HGB + 128 * 128 * 4 <= OFF_HGU, "ws map");
static_assert(WS_END <= 268435456ull, "workspace too large");
static_assert(OFF_P % 256 == 0 && OFF_KN % 256 == 0 && OFF_H % 256 == 0, "align");

struct Params {
    const float* x; const float* c; const int* pos; const float* norm_g; const float* w_mod; const float* b_mod; const float* w_in;
    const float* hg_lb; const float* hg_onorm; const float* g_cq; const float* w_uq; const float* g_ckv; const float* w_ukv;
    const float* w_pa; const float* w_pb; const float* w_pc; const float* w_out; const float* final_g;
    float* out; unsigned char* ws;
};


DI float bf2f(bf16_t v) { return __uint_as_float(((unsigned)v) << 16); }
DI unsigned pk2(float lo, float hi) { f32x2 v = {lo, hi}; bf16x2_t b = __builtin_convertvector(v, bf16x2_t); return __builtin_bit_cast(unsigned, b); }
DI bf16_t f2bf(float v) { return (bf16_t)(pk2(v, 0.f) & 0xffffu); }
DI u32x2 pk4(f32x4 v) { u32x2 r; r.x = pk2(v[0], v[1]); r.y = pk2(v[2], v[3]); return r; }
DI f32x4 unpk4(u32x2 u) { f32x4 r; r[0] = __uint_as_float(u.x << 16); r[1] = __uint_as_float(u.x & 0xffff0000u); r[2] = __uint_as_float(u.y << 16); r[3] = __uint_as_float(u.y & 0xffff0000u); return r; }
DI float sigmoidf_(float v) { return __builtin_amdgcn_rcpf(1.f + __builtin_amdgcn_exp2f(-1.4426950408889634f * v)); }
DI float siluf_(float v) { return v * __builtin_amdgcn_rcpf(1.f + __builtin_amdgcn_exp2f(-1.4426950408889634f * v)); }
DI int tid8_() { int t = threadIdx.x; asm volatile("" : "+v"(t)); return t; }
DI int tid_() { return tid8_() & 255; }
DI int vb_() { return __builtin_amdgcn_readfirstlane(tid8_() >> 8); }
DI int grab_item(unsigned* ctr, unsigned char* sm) {
    __syncthreads();
    if (tid8_() == 0) *(volatile int*)sm = (int)atomicAdd(ctr, 1u);
    __syncthreads();
    const int it = *(volatile int*)sm;
    __syncthreads();
    return it;
}
#define GB_GRP(g)  (64u * (1u + (g)))
#define GB_GGEN(g) (64u * (9u + (g)))
#define GB_TOP     (64u * 17u)
#define GB_TOPGEN  (64u * 18u)
DI unsigned gb_ld(unsigned* p) { return __hip_atomic_load(p, __ATOMIC_RELAXED, __HIP_MEMORY_SCOPE_AGENT); }
DI unsigned gb_add(unsigned* p) { return __hip_atomic_fetch_add(p, 1u, __ATOMIC_RELAXED, __HIP_MEMORY_SCOPE_AGENT); }
DI void grid_barrier(unsigned* bar, unsigned k) {
    asm volatile("s_waitcnt vmcnt(0)" ::: "memory");
    __syncthreads();
    if (tid8_() == 0) {
        const unsigned g = blockIdx.x & 7u, nloc = gridDim.x >> 3;
        __builtin_amdgcn_fence(__ATOMIC_RELEASE, "agent");
        asm volatile("s_waitcnt vmcnt(0)" ::: "memory");
        const unsigned old = gb_add(&bar[GB_GRP(g)]);
        if (old + 1u == k * nloc) {
            const unsigned og = gb_add(&bar[GB_TOP]);
            if (og + 1u == k * 8u) gb_add(&bar[GB_TOPGEN]);
            else while (gb_ld(&bar[GB_TOPGEN]) < k) __builtin_amdgcn_s_sleep(1);
            gb_add(&bar[GB_GGEN(g)]);
        } else {
            while (gb_ld(&bar[GB_GGEN(g)]) < k) __builtin_amdgcn_s_sleep(2);
        }
        __builtin_amdgcn_fence(__ATOMIC_ACQUIRE, "agent");
        asm volatile("s_waitcnt vmcnt(0)" ::: "memory");
    }
    __syncthreads();
}
DI int crow(int i, int hh) { return (i & 3) + 8 * (i >> 2) + 4 * hh; }
DI f32x16 mfma32(bf16x8 a, bf16x8 b, f32x16 c) { return __builtin_amdgcn_mfma_f32_32x32x16_bf16(a, b, c, 0, 0, 0); }
DI f32x4 mfma16(bf16x8 a, bf16x8 b, f32x4 c) { return __builtin_amdgcn_mfma_f32_16x16x32_bf16(a, b, c, 0, 0, 0); }
DI bf16x8 pack8(float a0, float a1, float a2, float a3, float a4, float a5, float a6, float a7) {
    u32x4 u; u.x = pk2(a0, a1); u.y = pk2(a2, a3); u.z = pk2(a4, a5); u.w = pk2(a6, a7); return __builtin_bit_cast(bf16x8, u);
}
DI bf16x8 join8(u32x2 lo, u32x2 hi) { u32x4 u; u.x = lo.x; u.y = lo.y; u.z = hi.x; u.w = hi.y; return __builtin_bit_cast(bf16x8, u); }
DI float warp_sum(float v) {
#pragma unroll
    for (int o = 32; o > 0; o >>= 1) v += __shfl_xor(v, o);
    return v;
}
DI void rope2(float& a, float& b, float ang) {
    const float n = rintf(ang * 0.15915493667125702f);
    float r = __builtin_fmaf(ang, 0.15915493667125702f, -n);
    r = __builtin_fmaf(ang, 6.4206382432985265e-09f, r);
    const float s = __builtin_amdgcn_sinf(r), c = __builtin_amdgcn_cosf(r);
    const float x1 = a, x2 = b; a = x1 * c - x2 * s; b = x2 * c + x1 * s;
}

DI int perm32(int rho) { return 8 * ((rho & 15) >> 2) + 4 * (rho >> 4) + (rho & 3); }
template <bool FRAG = false, bool PERM = false>
DI void conv_tile(const float* __restrict__ src, int ldsrc, int srccol0, int k0, bf16_t* dst, int lddst, int n0,
                  const float* __restrict__ rowscale, float sc, float* sm) {
    const int tid = tid_(), nn = tid & 31, kk0 = tid >> 5;
#pragma unroll 4
    for (int i = 0; i < 16; ++i) {
        const int kk = kk0 + 8 * i;
        float v = src[(size_t)(k0 + kk) * ldsrc + srccol0 + nn];
        if (rowscale) v *= rowscale[k0 + kk];
        sm[kk * 33 + nn] = v * sc;
    }
    __syncthreads();
    const int kp = 2 * (tid & 63), nb = tid >> 6;
#pragma unroll
    for (int i = 0; i < 8; ++i) {
        const int n = nb + 4 * i;
        const int ng = n0 + n, kg = k0 + kp;
        const size_t off = FRAG ? ((size_t)((ng >> 4) * (lddst >> 5) + (kg >> 5)) * 512 + (((ng & 15) + 16 * ((kg >> 3) & 3)) << 3) + (kg & 7)) : ((size_t)ng * lddst + kg);
        const int ns = PERM ? perm32(n) : n;
        *(unsigned*)(dst + off) = pk2(sm[kp * 33 + ns], sm[(kp + 1) * 33 + ns]);
    }
    __syncthreads();
}

constexpr int CONV_ITEMS = 1288 + 768 + 144 + 64 + 384 + 256;
DI void conv_weights(const Params& p, int l, int item, float* sm) {
    unsigned char* ws = p.ws;
    const float* w_in = p.w_in + (size_t)l * 1024 * DIN;
    if (item < 1288) { const int n0 = (item >> 3) * 32, kb = item & 7; const int sc0 = n0 < 3072 ? n0 : (n0 < 5120 ? n0 + 32 : 3072);
        if (n0 >= 5120) conv_tile(w_in, DIN, sc0, kb * 128, (bf16_t*)(ws + OFF_WKR), 1024, n0 - 5120, nullptr, 1.f, sm);
        else conv_tile<false, true>(w_in, DIN, sc0, kb * 128, (bf16_t*)(ws + OFF_KN), 1024, n0, nullptr, 1.f, sm);
        return; }
    item -= 1288;
    if (item < 768) { const int n0 = (item >> 3) * 32, kb = item & 7;
        conv_tile<false, true>(w_in, DIN, 5152 + n0, kb * 128, (bf16_t*)(ws + OFF_WM), 1024, n0, nullptr, 1.f, sm); return; }
    item -= 768;
    if (item < 144) { const int n0 = (item / 6) * 32, kb = item % 6; const int sc0 = n0 < 512 ? (n0 >> 6) * 96 + (n0 & 63) : ((n0 - 512) >> 5) * 96 + 64;
        conv_tile<true>(p.w_uq + (size_t)l * 768 * 768, 768, sc0, kb * 128, (bf16_t*)(ws + OFF_WUQ), 768, n0, p.g_cq + l * 768, QSCALE, sm); return; }
    item -= 144;
    if (item < 64) { const int n0 = (item >> 1) * 32, kb = item & 1;
        conv_tile(p.w_ukv + (size_t)l * 256 * 1024, 1024, n0, kb * 128, (bf16_t*)(ws + OFF_WUKV), 256, n0, p.g_ckv + l * 256, 1.f, sm); return; }
    item -= 64;
    if (item < 384) { const int br = item >> 7, r = item & 127, n0 = (r >> 2) * 32, kb = r & 3;
        const float* w = (br == 0 ? p.w_pa : (br == 1 ? p.w_pb : p.w_pc)) + (size_t)l * 512 * 1024;
        conv_tile<false, true>(w, 1024, n0, kb * 128, (bf16_t*)(ws + OFF_WP) + (size_t)br * 1024 * 512, 512, n0, nullptr, 1.f, sm); return; }
    item -= 384;
    { const int n0 = (item >> 3) * 32, kb = item & 7;
        conv_tile(p.w_out + (size_t)l * 1024 * 1024, 1024, n0, kb * 128, (bf16_t*)(ws + OFF_WOUT), 1024, n0, nullptr, 1.f, sm); }
}

DI void mod_item(const Params& p, int item, float* sm) {
    const int l = item / 96, n0 = (item % 96) * 32, tid = tid_(), nn = tid & 31, ks = tid >> 5;
    float* sc = sm + 1024;
    for (int e = tid; e < 2048; e += 256) sc[e] = siluf_(p.c[e]);
    __syncthreads();
    const float* w = p.w_mod + (size_t)l * 1024 * 3072 + n0 + nn + (size_t)(ks * 128) * 3072;
    float s0 = 0.f, s1 = 0.f;
#pragma unroll 1
    for (int k0 = 0; k0 < 128; k0 += 16) {
        float wv[16];
#pragma unroll
        for (int u = 0; u < 16; ++u) wv[u] = w[(size_t)(k0 + u) * 3072];
#pragma unroll
        for (int u = 0; u < 16; ++u) { s0 += sc[ks * 128 + k0 + u] * wv[u]; s1 += sc[1024 + ks * 128 + k0 + u] * wv[u]; }
    }
    sm[(ks * 32 + nn) * 2] = s0; sm[(ks * 32 + nn) * 2 + 1] = s1;
    __syncthreads();
    if (tid < 64) { const int n = tid & 31, b = tid >> 5; float s = 0.f;
        for (int q = 0; q < 8; ++q) s += sm[(q * 32 + n) * 2 + b];
        ((float*)(p.ws + OFF_MOD))[(l * 2 + b) * 3072 + n0 + n] = s + p.b_mod[l * 3072 + n0 + n]; }
    __syncthreads();
}
DI void lb_item(const Params& p) {
    float* LB = (float*)(p.ws + OFF_LB);
    for (int ch = tid_(); ch < 512; ch += 256) {
        const float l0 = p.hg_lb[ch], l1 = p.hg_lb[512 + ch];
        LB[ch] = 0.f; LB[512 + ch] = 1.f / (1.f + expf(l0 - l1));
    }
}

DI void norm_item(const Params& p, int l, int item) {
    const int tid__ = tid_(), lane = tid__ & 63, row = item * 4 + (tid__ >> 6), b = row >> 13;
    const float* xin = (l == 0 ? p.x : p.out) + (size_t)row * 1024;
    f32x4 v[4]; float ss = 0.f;
#pragma unroll
    for (int i = 0; i < 4; ++i) { v[i] = *(const f32x4*)(xin + lane * 4 + 256 * i); ss += v[i][0] * v[i][0] + v[i][1] * v[i][1] + v[i][2] * v[i][2] + v[i][3] * v[i][3]; }
    ss = warp_sum(ss);
    const float rstd = rsqrtf(ss * (1.f / 1024.f) + EPSF);
    const float* mod = (const float*)(p.ws + OFF_MOD) + (l * 2 + b) * 3072;
    bf16_t* h = (bf16_t*)(p.ws + OFF_H) + (size_t)row * 1024;
#pragma unroll
    for (int i = 0; i < 4; ++i) {
        const int col = lane * 4 + 256 * i;
        const f32x4 g = *(const f32x4*)(p.norm_g + l * 1024 + col), sh = *(const f32x4*)(mod + col), sc = *(const f32x4*)(mod + 1024 + col);
        f32x4 o;
#pragma unroll
        for (int j = 0; j < 4; ++j) o[j] = v[i][j] * rstd * g[j] * (1.f + sc[j]) + sh[j];
        *(u32x2*)(h + col) = pk4(o);
    }
    if (lane == 0) { float* ssq = (float*)(p.ws + OFF_SSQ) + row * 2; ssq[0] = 0.f; ssq[1] = 0.f; }
}
DI void final_item(const Params& p, int item) {
    const int tid__ = tid_(), lane = tid__ & 63, row = item * 4 + (tid__ >> 6);
    float* xr = p.out + (size_t)row * 1024;
    f32x4 v[4]; float ss = 0.f;
#pragma unroll
    for (int i = 0; i < 4; ++i) { v[i] = *(const f32x4*)(xr + lane * 4 + 256 * i); ss += v[i][0] * v[i][0] + v[i][1] * v[i][1] + v[i][2] * v[i][2] + v[i][3] * v[i][3]; }
    ss = warp_sum(ss);
    const float rstd = rsqrtf(ss * (1.f / 1024.f) + EPSF);
#pragma unroll
    for (int i = 0; i < 4; ++i) {
        const int col = lane * 4 + 256 * i; const f32x4 g = *(const f32x4*)(p.final_g + col);
        f32x4 o;
#pragma unroll
        for (int j = 0; j < 4; ++j) o[j] = v[i][j] * rstd * g[j];
        *(f32x4*)(xr + col) = o;
    }
}

template <int MT, int NT, int WN>
DI void gemm8(const bf16_t* A, int lda, const bf16_t* Bt, int ldb, int K, f32x4 (&acc)[MT][NT], unsigned char* smb) {
    constexpr int WM = 8 / WN, BM = 16 * MT * WM, BN = 16 * NT * WN;
    static_assert(BM == 256, "block tile is 256 rows");
    constexpr int A_B = BM * 128, B_B = BN * 128, ST_B = A_B + B_B, NA = BM / 64, NB = BN / 64;
    const int tid = tid8_(), lane = tid & 63, wave = tid >> 6, wm = wave / WN, wn = wave % WN;
    const int fr = lane & 15, fq = lane >> 4, lr = lane >> 3, pc = lane & 7;
    const bf16_t* ag[NA]; const bf16_t* bg[NB];
#pragma unroll
    for (int i = 0; i < NA; ++i) { const int row = 8 * (8 * i + wave) + lr, c = pc ^ ((row >> 1) & 7); ag[i] = A + (size_t)row * lda + c * 8; }
#pragma unroll
    for (int i = 0; i < NB; ++i) { const int row = 8 * (8 * i + wave) + lr, c = pc ^ ((row >> 1) & 7); bg[i] = Bt + (size_t)row * ldb + c * 8; }
    auto stage = [&](int buf, int ko) {
#pragma unroll
        for (int i = 0; i < NA; ++i) __builtin_amdgcn_global_load_lds((const unsigned*)(ag[i] + ko), (unsigned*)(smb + buf * ST_B + (8 * i + wave) * 1024), 16, 0, 0);
#pragma unroll
        for (int i = 0; i < NB; ++i) __builtin_amdgcn_global_load_lds((const unsigned*)(bg[i] + ko), (unsigned*)(smb + buf * ST_B + A_B + (8 * i + wave) * 1024), 16, 0, 0);
    };
    const int KT = K >> 6;
    const int swz = fr >> 1;
    const int aoff = (16 * MT * wm + fr) * 128, boff = A_B + (16 * NT * wn + fr) * 128;
    stage(0, 0);
    asm volatile("s_waitcnt vmcnt(0)" ::: "memory");
    __syncthreads();
#pragma unroll 1
    for (int kt = 0; kt < KT; ++kt) {
        const int cur = kt & 1;
        if (kt + 1 < KT) stage(cur ^ 1, (kt + 1) * 64);
        const unsigned char* sb = smb + cur * ST_B;
#pragma unroll
        for (int ks = 0; ks < 2; ++ks) {
            const int co = ((4 * ks + fq) ^ swz) << 4;
            bf16x8 af[MT], bf[NT];
#pragma unroll
            for (int i = 0; i < MT; ++i) af[i] = *(const bf16x8*)(sb + aoff + i * 2048 + co);
#pragma unroll
            for (int j = 0; j < NT; ++j) bf[j] = *(const bf16x8*)(sb + boff + j * 2048 + co);
#pragma unroll
            for (int i = 0; i < MT; ++i)
#pragma unroll
                for (int j = 0; j < NT; ++j) acc[i][j] = mfma16(bf[j], af[i], acc[i][j]);
        }
        asm volatile("s_waitcnt vmcnt(0)" ::: "memory");
        __syncthreads();
    }
}
template <int MT, int NT> DI void zero_acc(f32x4 (&acc)[MT][NT]) {
#pragma unroll
    for (int i = 0; i < MT; ++i)
#pragma unroll
        for (int j = 0; j < NT; ++j) acc[i][j] = (f32x4){0.f, 0.f, 0.f, 0.f};
}

constexpr int INPROJ_NT = 20;
DI void inproj_item(const Params& p, int mt, int nt, unsigned char* smb, int dry) {
    const int m0 = mt * 256, n0 = nt * 256;
    f32x4 acc[8][4]; zero_acc<8, 4>(acc);
    gemm8<8, 4, 4>((const bf16_t*)(p.ws + OFF_H) + (size_t)m0 * 1024, 1024, (const bf16_t*)(p.ws + OFF_KN) + (size_t)n0 * 1024, 1024, 1024, acc, smb);
    const int tid = tid8_(), lane = tid & 63, wave = tid >> 6, wm = wave >> 2, wn = wave & 3, fr = lane & 15, fq = lane >> 4;
    const int cb = n0 + 64 * wn;
    bf16_t* P = (bf16_t*)(p.ws + OFF_P);
    const int rbase = m0 + 128 * wm + fr;
    if (cb >= C_RQ && cb < C_RV) {
        const float sc = cb >= C_RK ? 0.125f : 1.f;
#pragma unroll
        for (int i = 0; i < 8; ++i) {
            const int row = rbase + 16 * i; const float pos = (float)p.pos[row];
#pragma unroll
            for (int j = 0; j < 2; ++j)
#pragma unroll
                for (int jj = 0; jj < 4; ++jj) {
                    const int d = 8 * fq + 4 * j + jj; const float inv = exp2f(-(float)d * (LOG2_1E4 / 32.f));
                    float a = acc[i][j][jj], b = acc[i][j + 2][jj]; rope2(a, b, pos * inv); acc[i][j][jj] = a * sc; acc[i][j + 2][jj] = b * sc;
                }
#pragma unroll
            for (int g = 0; g < 2; ++g) { const u32x2 lo = pk4(acc[i][2 * g]), hi = pk4(acc[i][2 * g + 1]);
                *(u32x4*)(P + (size_t)row * PC + cb + 32 * g + 8 * fq) = (u32x4){lo.x, lo.y, hi.x, hi.y}; }
        }
    } else {
        const bool is_silu = (cb >= C_HG && cb < C_CQ) || (cb >= C_GB && cb < C_RQ) || (cb >= C_RG && cb < C_KR);
        const bool is_hq = cb < C_HZ;
        const bool is_cq = cb >= C_CQ && cb < C_CKV, is_ckv = cb >= C_CKV && cb < C_GB;
#pragma unroll
        for (int i = 0; i < 8; ++i) {
            const int row = rbase + 16 * i;
            if (is_cq || is_ckv) {
                float s = 0.f;
#pragma unroll
                for (int j = 0; j < 4; ++j) s += acc[i][j][0] * acc[i][j][0] + acc[i][j][1] * acc[i][j][1] + acc[i][j][2] * acc[i][j][2] + acc[i][j][3] * acc[i][j][3];
                s += __shfl_xor(s, 16); s += __shfl_xor(s, 32);
                if (fq == 0 && !dry) atomicAdd((float*)(p.ws + OFF_SSQ) + row * 2 + (is_ckv ? 1 : 0), s);
            }
#pragma unroll
            for (int g = 0; g < 2; ++g) {
                f32x4 v0 = acc[i][2 * g], v1 = acc[i][2 * g + 1];
                if (is_silu) {
#pragma unroll
                    for (int jj = 0; jj < 4; ++jj) { v0[jj] = siluf_(v0[jj]); v1[jj] = siluf_(v1[jj]); }
                } else if (is_hq) {
#pragma unroll
                    for (int jj = 0; jj < 4; ++jj) { v0[jj] = siluf_(v0[jj]) * 0.08838834764831845f; v1[jj] = siluf_(v1[jj]) * 0.08838834764831845f; }
                }
                const u32x2 lo = pk4(v0), hi = pk4(v1);
                *(u32x4*)(P + (size_t)row * PC + cb + 32 * g + 8 * fq) = (u32x4){lo.x, lo.y, hi.x, hi.y};
            }
        }
    }
}

DI void kr_item(const Params& p, int item) {
    const int tid = tid8_(), lane = tid & 63, wave = tid >> 6, fr = lane & 15, fq = lane >> 4;
    const int r0 = item * 256 + 32 * wave;
    const bf16_t* ap = (const bf16_t*)(p.ws + OFF_H) + (size_t)(r0 + fr) * 1024 + 8 * fq;
    const bf16_t* bp = (const bf16_t*)(p.ws + OFF_WKR) + (size_t)fr * 1024 + 8 * fq;
    f32x4 acc[2][2];
#pragma unroll
    for (int i = 0; i < 2; ++i)
#pragma unroll
        for (int j = 0; j < 2; ++j) acc[i][j] = (f32x4){0.f, 0.f, 0.f, 0.f};
#pragma unroll 4
    for (int ks = 0; ks < 32; ++ks) {
        const bf16x8 a0 = *(const bf16x8*)(ap + 32 * ks), a1 = *(const bf16x8*)(ap + 16 * 1024 + 32 * ks);
        const bf16x8 b0 = *(const bf16x8*)(bp + 32 * ks), b1 = *(const bf16x8*)(bp + 16 * 1024 + 32 * ks);
        acc[0][0] = mfma16(b0, a0, acc[0][0]); acc[0][1] = mfma16(b1, a0, acc[0][1]);
        acc[1][0] = mfma16(b0, a1, acc[1][0]); acc[1][1] = mfma16(b1, a1, acc[1][1]);
    }
    bf16_t* P = (bf16_t*)(p.ws + OFF_P);
#pragma unroll
    for (int i = 0; i < 2; ++i) {
        const int row = r0 + 16 * i + fr; const float pos = (float)p.pos[row];
#pragma unroll
        for (int jj = 0; jj < 4; ++jj) {
            const int d = 4 * fq + jj; const float inv = exp2f(-(float)d * (LOG2_1E4 / 16.f));
            float a = acc[i][0][jj], b = acc[i][1][jj]; rope2(a, b, pos * inv); acc[i][0][jj] = a; acc[i][1][jj] = b;
        }
#pragma unroll
        for (int j = 0; j < 2; ++j) *(u32x2*)(P + (size_t)row * PC + C_KR + 16 * j + 4 * fq) = pk4(acc[i][j]);
    }
}

DI void kvup_item(const Params& p, int mt, int nt, unsigned char* smb) {
    const int m0 = mt * 256, n0 = nt * 256;
    f32x4 acc[8][4]; zero_acc<8, 4>(acc);
    gemm8<8, 4, 4>((const bf16_t*)(p.ws + OFF_P) + (size_t)m0 * PC + C_CKV, PC, (const bf16_t*)(p.ws + OFF_WUKV) + (size_t)n0 * 256, 256, 256, acc, smb);
    const int tid = tid8_(), lane = tid & 63, wave = tid >> 6, wm = wave >> 2, wn = wave & 3, fr = lane & 15, fq = lane >> 4;
    const int cs = n0 + 64 * wn, head = cs >> 7, isv = (cs >> 6) & 1;
    bf16_t* KN = (bf16_t*)(p.ws + OFF_KN); bf16_t* VT = (bf16_t*)(p.ws + OFF_VT);
    const float* ssq = (const float*)(p.ws + OFF_SSQ);
#pragma unroll
    for (int i = 0; i < 8; ++i) {
        const int row = m0 + 128 * wm + 16 * i + fr;
        const float rstd = rsqrtf(ssq[row * 2 + 1] * (1.f / 256.f) + EPSF);
#pragma unroll
        for (int j = 0; j < 4; ++j) {
            f32x4 v = acc[i][j] * rstd; const int w = 16 * j + 4 * fq;
            if (!isv) *(u32x2*)(KN + (size_t)row * 512 + head * 64 + w) = pk4(v);
            else { const int b = row >> 13, t = row & 8191;
#pragma unroll
                for (int jj = 0; jj < 4; ++jj) VT[((size_t)((b * 8 + head) * 64 + w + jj)) * SEQ + t] = f2bf(v[jj]); }
        }
    }
}

DI void qup_item(const Params& p, int item, bf16_t* sm, int dry) {
    const int m0 = item * 64, tid = tid8_(), lane = tid & 63, wave = tid >> 6, fr = lane & 15, fq = lane >> 4;
    bf16_t* P = (bf16_t*)(p.ws + OFF_P);
    constexpr int AP = 776;
#pragma unroll
    for (int i = 0; i < 12; ++i) { const int c = tid + 512 * i, r = c / 96, cc = c % 96;
        *(u32x4*)(sm + r * AP + cc * 8) = *(const u32x4*)(P + (size_t)(m0 + r) * PC + C_CQ + cc * 8); }
    __syncthreads();
    const bf16_t* W = (const bf16_t*)(p.ws + OFF_WUQ);
    const int nc0 = 96 * wave;
    f32x4 acc[4][6];
#pragma unroll
    for (int i = 0; i < 4; ++i)
#pragma unroll
        for (int j = 0; j < 6; ++j) acc[i][j] = (f32x4){0.f, 0.f, 0.f, 0.f};
    const bf16_t* wp = W + (size_t)(nc0 >> 4) * 24 * 512 + lane * 8;
    bf16x8 bq[3][6];
#pragma unroll
    for (int u = 0; u < 3; ++u)
#pragma unroll
        for (int j = 0; j < 6; ++j) bq[u][j] = *(const bf16x8*)(wp + (size_t)(j * 24 + u) * 512);
#pragma unroll 1
    for (int ks0 = 0; ks0 < 24; ks0 += 3) {
#pragma unroll
        for (int u = 0; u < 3; ++u) {
            const int ks = ks0 + u;
            bf16x8 af[4];
#pragma unroll
            for (int i = 0; i < 4; ++i) af[i] = *(const bf16x8*)(sm + (16 * i + fr) * AP + 32 * ks + 8 * fq);
#pragma unroll
            for (int j = 0; j < 6; ++j) {
#pragma unroll
                for (int i = 0; i < 4; ++i) acc[i][j] = mfma16(bq[u][j], af[i], acc[i][j]);
            }
            if (ks + 3 < 24) {
#pragma unroll
                for (int j = 0; j < 6; ++j) bq[u][j] = *(const bf16x8*)(wp + (size_t)(j * 24 + ks + 3) * 512);
            }
        }
    }
    const float* ssq = (const float*)(p.ws + OFF_SSQ);
#pragma unroll
    for (int i = 0; i < 4; ++i) {
        const int row = m0 + 16 * i + fr; const float rstd = rsqrtf(ssq[row * 2] * (1.f / 768.f) + EPSF); const float pos = (float)p.pos[row];
#pragma unroll
        for (int j = 0; j < 6; j += 2) {
            f32x4 a = acc[i][j] * rstd, b = acc[i][j + 1] * rstd; const int col = nc0 + 16 * j;
            if (col >= 512) {
#pragma unroll
                for (int jj = 0; jj < 4; ++jj) { const int d = 4 * fq + jj; const float inv = exp2f(-(float)d * (LOG2_1E4 / 16.f)); float x1 = a[jj], x2 = b[jj]; rope2(x1, x2, pos * inv); a[jj] = x1; b[jj] = x2; }
            }
            if (!dry) { *(u32x2*)(P + (size_t)row * PC + C_CQ + col + 4 * fq) = pk4(a);
            *(u32x2*)(P + (size_t)row * PC + C_CQ + col + 16 + 4 * fq) = pk4(b); }
        }
    }
    __syncthreads();
}

DI void attn_item(const Params& p, int qt, int bh, bf16_t* sm, int dry) {
    const int b = bh >> 3, h = bh & 7;
    const int tid = tid8_(), lane = tid & 63, wave = tid >> 6, ql = lane & 31, hh = lane >> 5;
    const int q0 = qt * 256, tokbase = b * SEQ;
    bf16_t* P = (bf16_t*)(p.ws + OFF_P);
    const bf16_t* KN = (const bf16_t*)(p.ws + OFF_KN); const bf16_t* VT = (const bf16_t*)(p.ws + OFF_VT) + (size_t)((b * 8 + h) * 64) * SEQ;
    const int qrow = tokbase + q0 + 32 * wave + ql;
    bf16x8 qf[6];
    { const bf16_t* qp = P + (size_t)qrow * PC + C_CQ;
#pragma unroll
      for (int ks = 0; ks < 4; ++ks) qf[ks] = *(const bf16x8*)(qp + h * 64 + 16 * ks + 8 * hh);
#pragma unroll
      for (int ks = 0; ks < 2; ++ks) qf[4 + ks] = *(const bf16x8*)(qp + 512 + h * 32 + 16 * ks + 8 * hh); }
    constexpr int KP = 104, VP = 136, KSZ = 128 * KP, VSZ = 64 * VP;
    bf16_t* Ks = sm; bf16_t* Vs = sm + 2 * KSZ;
    f32x16 o[2];
#pragma unroll
    for (int i = 0; i < 16; ++i) { o[0][i] = 0.f; o[1][i] = 0.f; }
    float mrun = 0.f, lsum = 0.f;
    const int nkt = 2 * qt + 2;
    const int qg = q0 + 32 * wave + ql;
    u32x4 rk[3], rv[2];
    auto gload = [&](int kt) {
        const int k0 = tokbase + kt * 128;
#pragma unroll
        for (int i = 0; i < 3; ++i) {
            const int c = tid + 512 * i, key = c / 12, cc = c % 12, tok = k0 + key;
            rk[i] = *(const u32x4*)(cc < 8 ? KN + (size_t)tok * 512 + h * 64 + cc * 8 : P + (size_t)tok * PC + C_KR + (cc - 8) * 8);
        }
#pragma unroll
        for (int i = 0; i < 2; ++i) { const int c = tid + 512 * i; rv[i] = *(const u32x4*)(VT + (size_t)(c >> 4) * SEQ + kt * 128 + (c & 15) * 8); }
    };
    gload(0);
#pragma unroll 1
    for (int kt = 0; kt < nkt; ++kt) {
        const int buf = kt & 1;
        bf16_t* Kb = Ks + buf * KSZ; bf16_t* Vb = Vs + buf * VSZ;
#pragma unroll
        for (int i = 0; i < 3; ++i) { const int c = tid + 512 * i; *(u32x4*)(Kb + (c / 12) * KP + (c % 12) * 8) = rk[i]; }
#pragma unroll
        for (int i = 0; i < 2; ++i) { const int c = tid + 512 * i; *(u32x4*)(Vb + (c >> 4) * VP + (c & 15) * 8) = rv[i]; }
        __syncthreads();
        if (kt + 1 < nkt) gload(kt + 1);
        f32x16 s[4];
        __builtin_amdgcn_s_setprio(1);
        {
#pragma unroll
            for (int sub = 0; sub < 4; ++sub)
#pragma unroll
                for (int i = 0; i < 16; ++i) s[sub][i] = -mrun;
#pragma unroll
            for (int sub = 0; sub < 4; ++sub)
#pragma unroll
                for (int ks = 0; ks < 6; ++ks) {
                    const bf16x8 kf = *(const bf16x8*)(Kb + (32 * sub + ql) * KP + 16 * ks + 8 * hh);
                    s[sub] = mfma32(kf, qf[ks], s[sub]);
                }
            __builtin_amdgcn_sched_group_barrier(0x100, 8, 0);
#pragma unroll
            for (int u = 0; u < 16; ++u) { __builtin_amdgcn_sched_group_barrier(0x008, 1, 0); __builtin_amdgcn_sched_group_barrier(0x100, 1, 0); }
            __builtin_amdgcn_sched_group_barrier(0x008, 8, 0);
        }
        __builtin_amdgcn_s_setprio(0);
        if (kt >= nkt - 2) {
#pragma unroll
            for (int sub = 0; sub < 4; ++sub)
#pragma unroll
                for (int i = 0; i < 16; ++i) { const int kg = kt * 128 + 32 * sub + crow(i, hh); if (kg > qg) s[sub][i] = -1e30f; }
        }
        float mx = s[0][0];
#pragma unroll
        for (int sub = 0; sub < 4; ++sub)
#pragma unroll
            for (int i = 0; i < 16; ++i) mx = fmaxf(mx, s[sub][i]);
        mx = fmaxf(mx, __shfl_xor(mx, 32));
        if (__builtin_amdgcn_ballot_w64(mx > 0.f) != 0) {
            const float delta = fmaxf(mx, 0.f), alpha = __builtin_amdgcn_exp2f(-delta);
            mrun += delta; lsum *= alpha;
#pragma unroll
            for (int i = 0; i < 16; ++i) { s[0][i] -= delta; s[1][i] -= delta; s[2][i] -= delta; s[3][i] -= delta; o[0][i] *= alpha; o[1][i] *= alpha; }
        }
        f32x2 rs2 = {0.f, 0.f};
#pragma unroll
        for (int sub = 0; sub < 4; ++sub)
#pragma unroll
            for (int i = 0; i < 16; i += 2) {
                s[sub][i] = __builtin_amdgcn_exp2f(s[sub][i]); s[sub][i + 1] = __builtin_amdgcn_exp2f(s[sub][i + 1]);
                rs2 += (f32x2){s[sub][i], s[sub][i + 1]};
            }
        lsum += rs2[0] + rs2[1];
#pragma unroll
        for (int sub = 0; sub < 4; ++sub)
#pragma unroll
            for (int s2 = 0; s2 < 2; ++s2) {
                const bf16x8 pf = pack8(s[sub][8 * s2], s[sub][8 * s2 + 1], s[sub][8 * s2 + 2], s[sub][8 * s2 + 3], s[sub][8 * s2 + 4], s[sub][8 * s2 + 5], s[sub][8 * s2 + 6], s[sub][8 * s2 + 7]);
#pragma unroll
                for (int dt = 0; dt < 2; ++dt) {
                    const bf16_t* vp = Vb + (32 * dt + ql) * VP + 32 * sub + 16 * s2 + 4 * hh;
                    const bf16x8 vf = join8(*(const u32x2*)vp, *(const u32x2*)(vp + 8));
                    o[dt] = mfma32(vf, pf, o[dt]);
                }
            }
        __builtin_amdgcn_sched_group_barrier(0x100, 4, 1);
#pragma unroll
        for (int u = 0; u < 12; ++u) { __builtin_amdgcn_sched_group_barrier(0x008, 1, 1); __builtin_amdgcn_sched_group_barrier(0x100, 1, 1); }
        __builtin_amdgcn_sched_group_barrier(0x008, 4, 1);
    }
    lsum += __shfl_xor(lsum, 32);
    const float inv = 1.f / lsum;
    bf16_t* gp = P + (size_t)qrow * PC + C_GB + h * 64;
#pragma unroll
    for (int dt = 0; dt < 2; ++dt)
#pragma unroll
        for (int g = 0; g < 4; ++g) {
            const int dv = 32 * dt + 8 * g + 4 * hh;
            const f32x4 gate = unpk4(*(const u32x2*)(gp + dv));
            f32x4 y;
#pragma unroll
            for (int jj = 0; jj < 4; ++jj) y[jj] = o[dt][4 * g + jj] * inv * gate[jj];
            if (!dry) *(u32x2*)(gp + dv) = pk4(y);
        }
    __syncthreads();
}

template <int DK, bool RET, bool OUT>
DI void gla_item(const Params& p, int l, int item, unsigned char* smraw, int dry) {
    constexpr int NT = DK / 32, NP = 256 / DK, TP = 32 / NP, PQ = DK + 8, PT = 40;
    const int b = item >> 6, h = (item >> 4) & 3, seg = item & 15;
    const int tid = tid_(), lane = tid & 63, wave = tid >> 6, ql = lane & 31, hh = lane >> 5;
    bf16_t* Qt = (bf16_t*)smraw; bf16_t* Qh = Qt + 32 * PQ; bf16_t* Kt = Qh + 32 * PQ; bf16_t* KhT = Kt + 32 * PQ; bf16_t* VTs = KhT + DK * PT;
    float* tots = (float*)(VTs + 128 * PT); float* decs = tots + NP * DK; float* sums = decs + DK;
    bf16_t* P = (bf16_t*)(p.ws + OFF_P);
    const int tok0 = b * SEQ + seg * 512;
    const int qcol = RET ? C_RQ + h * 64 : C_HQ + h * 128, kcol = RET ? C_RK + h * 64 : C_HZ + h * 128;
    const int vcol = (RET ? C_RV : C_HV) + h * 128, gcol = (RET ? C_RG : C_HG) + h * 128;
    float* U = (float*)(p.ws + (RET ? OFF_RTU : OFF_HGU)); constexpr int USZ = DK * 128;
    float* HB = (float*)(p.ws + OFF_HGB);
    const float lgam = log1pf(-exp2f(-5.f - (float)h));
    f32x16 S[NT];
#pragma unroll
    for (int t = 0; t < NT; ++t)
#pragma unroll
        for (int i = 0; i < 16; ++i) S[t][i] = 0.f;
    if (OUT) {
        float* dall = (float*)smraw;
        if (!RET) {
            for (int e = tid; e < seg * 128; e += 256) dall[e] = __expf(HB[(item - seg) * 128 + e]);
            __syncthreads();
        }
        const float rdec = __expf(512.f * lgam);
#pragma unroll 2
        for (int m = 0; m < seg; ++m) {
            const int it2 = item - seg + m;
#pragma unroll
            for (int t = 0; t < NT; ++t)
#pragma unroll
                for (int i = 0; i < 16; ++i) {
                    const float dec = RET ? rdec : dall[m * 128 + 32 * t + crow(i, hh)];
                    S[t][i] = S[t][i] * dec + U[(size_t)it2 * USZ + (t * 16 + i) * 256 + tid];
                }
        }
    }
    const int d = tid % DK, part = tid / DK;
    const float lbv = RET ? 0.f : ((const float*)(p.ws + OFF_LB))[l * 512 + h * 128 + d];
    float btot_run = 0.f;
    const int vdv = tid & 127, vhalf = tid >> 7;
    unsigned rq[TP], rz[TP], rv[16];
    auto prefetch = [&](int ch) {
        const int t0 = tok0 + ch * 32;
#pragma unroll
        for (int t = 0; t < TP; ++t) {
            const bf16_t* row = P + (size_t)(t0 + part * TP + t) * PC;
            if (OUT) rq[t] = row[qcol + d];
            rz[t] = row[kcol + d];
        }
#pragma unroll
        for (int t = 0; t < 16; ++t) rv[t] = P[(size_t)(t0 + vhalf * 16 + t) * PC + vcol + vdv];
    };
    prefetch(0);
#pragma unroll 1
    for (int ch = 0; ch < 16; ++ch) {
        const int t0 = tok0 + ch * 32;
        float run = 0.f;
        float lfv[TP], kvs[TP];
#pragma unroll
        for (int t = 0; t < TP; ++t) {
            const float z = __uint_as_float(rz[t] << 16);
            if (RET) { kvs[t] = z; lfv[t] = lgam; }
            else {
                const float sg = __builtin_amdgcn_rcpf(1.f + __builtin_amdgcn_exp2f(-1.4426950408889634f * z));
                lfv[t] = __logf(fmaxf(lbv + (1.f - lbv) * sg, 1e-20f));
                kvs[t] = (1.f - lbv) * (1.f - sg);
            }
            run += lfv[t];
        }
        tots[part * DK + d] = run;
        *(u32x4*)(VTs + vdv * PT + vhalf * 16) = (u32x4){rv[0] | (rv[1] << 16), rv[2] | (rv[3] << 16), rv[4] | (rv[5] << 16), rv[6] | (rv[7] << 16)};
        *(u32x4*)(VTs + vdv * PT + vhalf * 16 + 8) = (u32x4){rv[8] | (rv[9] << 16), rv[10] | (rv[11] << 16), rv[12] | (rv[13] << 16), rv[14] | (rv[15] << 16)};
        __syncthreads();
        float base = 0.f, rref = 0.f, blast = 0.f;
#pragma unroll
        for (int pp = 0; pp < NP; ++pp) { const float tt = tots[pp * DK + d]; if (pp < part) base += tt; if (pp < NP / 2) rref += tt; blast += tt; }
        unsigned khp[TP / 2];
        float bt = base;
        const float er = __expf(rref), ebr = __expf(blast - rref);
#pragma unroll
        for (int t = 0; t < TP; ++t) {
            const float kvv = kvs[t];
            bt += lfv[t];
            const int tr = part * TP + t;
            unsigned khb;
            if (OUT) {
                const float qv = __uint_as_float(rq[t] << 16);
                const float e1 = __expf(bt - rref), e2 = __builtin_amdgcn_rcpf(e1);
                Qt[tr * PQ + d] = f2bf(qv * e1);
                Qh[tr * PQ + d] = f2bf(qv * e1 * er);
                Kt[tr * PQ + d] = f2bf(kvv * e2);
                khb = f2bf(kvv * e2 * ebr);
            } else {
                khb = f2bf(kvv * __expf(blast - bt));
            }
            if (t & 1) khp[t >> 1] |= khb << 16; else khp[t >> 1] = khb;
        }
        *(u32x4*)(KhT + d * PT + part * TP) = (u32x4){khp[0], khp[1], khp[2], khp[3]};
        if (TP == 16) *(u32x4*)(KhT + d * PT + part * TP + 8) = (u32x4){khp[TP / 2 - 4], khp[TP / 2 - 3], khp[TP / 2 - 2], khp[TP / 2 - 1]};
        if (part == 0) { decs[d] = __expf(blast); btot_run += blast; }
        if (ch + 1 < 16) prefetch(ch + 1);
        __syncthreads();
        f32x16 o;
        u32x2 gate_r[4];
        if (OUT) {
#pragma unroll
            for (int g = 0; g < 4; ++g) gate_r[g] = *(const u32x2*)(P + (size_t)(t0 + ql) * PC + gcol + 32 * wave + 8 * g + 4 * hh);
        }
        if (OUT) {
            f32x16 at;
#pragma unroll
            for (int i = 0; i < 16; ++i) { at[i] = 0.f; o[i] = 0.f; }
#pragma unroll
            for (int ks = 0; ks < DK / 16; ++ks) {
                const bf16x8 kf = *(const bf16x8*)(Kt + ql * PQ + 16 * ks + 8 * hh);
                const bf16x8 qf = *(const bf16x8*)(Qt + ql * PQ + 16 * ks + 8 * hh);
                at = mfma32(kf, qf, at);
            }
#pragma unroll
            for (int i = 0; i < 16; ++i) if (crow(i, hh) > ql) at[i] = 0.f;
#pragma unroll
            for (int s2 = 0; s2 < 2; ++s2) {
                const bf16x8 pa = pack8(at[8 * s2], at[8 * s2 + 1], at[8 * s2 + 2], at[8 * s2 + 3], at[8 * s2 + 4], at[8 * s2 + 5], at[8 * s2 + 6], at[8 * s2 + 7]);
                const bf16_t* vp = VTs + (32 * wave + ql) * PT + 16 * s2 + 4 * hh;
                o = mfma32(join8(*(const u32x2*)vp, *(const u32x2*)(vp + 8)), pa, o);
            }
#pragma unroll
            for (int t = 0; t < NT; ++t)
#pragma unroll
                for (int s2 = 0; s2 < 2; ++s2) {
                    const bf16x8 sf = pack8(S[t][8 * s2], S[t][8 * s2 + 1], S[t][8 * s2 + 2], S[t][8 * s2 + 3], S[t][8 * s2 + 4], S[t][8 * s2 + 5], S[t][8 * s2 + 6], S[t][8 * s2 + 7]);
                    const bf16_t* qp = Qh + ql * PQ + 32 * t + 16 * s2 + 4 * hh;
                    o = mfma32(sf, join8(*(const u32x2*)qp, *(const u32x2*)(qp + 8)), o);
                }
        }
#pragma unroll
        for (int t = 0; t < NT; ++t) {
#pragma unroll
            for (int i = 0; i < 16; ++i) S[t][i] *= decs[32 * t + crow(i, hh)];
#pragma unroll
            for (int s2 = 0; s2 < 2; ++s2) {
                const bf16x8 kf = *(const bf16x8*)(KhT + (32 * t + ql) * PT + 16 * s2 + 8 * hh);
                const bf16x8 vf = *(const bf16x8*)(VTs + (32 * wave + ql) * PT + 16 * s2 + 8 * hh);
                S[t] = mfma32(kf, vf, S[t]);
            }
        }
        if (OUT) {
            float ss = 0.f;
#pragma unroll
            for (int i = 0; i < 16; ++i) ss += o[i] * o[i];
            ss += __shfl_xor(ss, 32);
            if (hh == 0) sums[wave * 32 + ql] = ss;
            __syncthreads();
            const float tot = sums[ql] + sums[32 + ql] + sums[64 + ql] + sums[96 + ql];
            const float rstd = rsqrtf(tot * (1.f / 128.f) + EPSF);
            bf16_t* gp = P + (size_t)(t0 + ql) * PC + gcol;
#pragma unroll
            for (int g = 0; g < 4; ++g) {
                const int dv = 32 * wave + 8 * g + 4 * hh;
                const f32x4 gate = unpk4(gate_r[g]);
                f32x4 y;
#pragma unroll
                for (int jj = 0; jj < 4; ++jj) { const float gn = RET ? 1.f : p.hg_onorm[l * 128 + dv + jj]; y[jj] = o[4 * g + jj] * rstd * gn * gate[jj]; }
                if (!dry) *(u32x2*)(gp + dv) = pk4(y);
            }
        } else {
            __syncthreads();
        }
    }
    if (!OUT) {
#pragma unroll
        for (int t = 0; t < NT; ++t)
#pragma unroll
            for (int i = 0; i < 16; ++i) U[(size_t)item * USZ + (t * 16 + i) * 256 + tid] = S[t][i];
        if (!RET && part == 0) HB[item * 128 + d] = btot_run;
    }
    __syncthreads();
}

DI void merge_item(const Params& p, int mt, int nt, unsigned char* smb) {
    const int m0 = mt * 256, n0 = nt * 128;
    f32x4 am[4][4]; zero_acc<4, 4>(am);
    const bf16_t* H = (const bf16_t*)(p.ws + OFF_H) + (size_t)m0 * 1024;
    bf16_t* P = (bf16_t*)(p.ws + OFF_P);
#pragma unroll 1
    for (int br = 0; br < 3; ++br) {
        const int ycol = br == 0 ? C_HG : (br == 1 ? C_GB : C_RG);
        u32x2 sg[4][4];
        { f32x4 ag[4][4]; zero_acc<4, 4>(ag);
          gemm8<4, 4, 2>(H, 1024, (const bf16_t*)(p.ws + OFF_WM) + (size_t)(br * 1024 + n0) * 1024, 1024, 1024, ag, smb);
#pragma unroll
          for (int i = 0; i < 4; ++i)
#pragma unroll
              for (int j = 0; j < 4; ++j) { f32x4 g;
#pragma unroll
                  for (int jj = 0; jj < 4; ++jj) g[jj] = sigmoidf_(ag[i][j][jj]);
                  sg[i][j] = pk4(g); } }
        f32x4 ay[4][4]; zero_acc<4, 4>(ay);
        gemm8<4, 4, 2>(P + (size_t)m0 * PC + ycol, PC, (const bf16_t*)(p.ws + OFF_WP) + (size_t)br * 1024 * 512 + (size_t)n0 * 512, 512, 512, ay, smb);
#pragma unroll
        for (int i = 0; i < 4; ++i)
#pragma unroll
            for (int j = 0; j < 4; ++j) { const f32x4 g = unpk4(sg[i][j]);
#pragma unroll
                for (int jj = 0; jj < 4; ++jj) am[i][j][jj] += g[jj] * ay[i][j][jj]; }
    }
    const int tid = tid8_(), lane = tid & 63, wave = tid >> 6, wm = wave >> 1, wn = wave & 1, fr = lane & 15, fq = lane >> 4;
#pragma unroll
    for (int i = 0; i < 4; ++i) {
        const int row = m0 + 64 * wm + 16 * i + fr;
#pragma unroll
        for (int g = 0; g < 2; ++g) { const u32x2 lo = pk4(am[i][2 * g]), hi = pk4(am[i][2 * g + 1]);
            *(u32x4*)(P + (size_t)row * PC + n0 + 64 * wn + 32 * g + 8 * fq) = (u32x4){lo.x, lo.y, hi.x, hi.y}; }
    }
}

DI void out_item(const Params& p, int l, int mt, int nt, unsigned char* smb, int dry) {
    const int m0 = mt * 256, n0 = nt * 256;
    f32x4 acc[8][4]; zero_acc<8, 4>(acc);
    gemm8<8, 4, 4>((const bf16_t*)(p.ws + OFF_P) + (size_t)m0 * PC, PC, (const bf16_t*)(p.ws + OFF_WOUT) + (size_t)n0 * 1024, 1024, 1024, acc, smb);
    const int tid = tid8_(), lane = tid & 63, wave = tid >> 6, wm = wave >> 2, wn = wave & 3, fr = lane & 15, fq = lane >> 4;
    const float* xin = l == 0 ? p.x : p.out;
#pragma unroll
    for (int i = 0; i < 8; ++i) {
        const int row = m0 + 128 * wm + 16 * i + fr, b = row >> 13;
        const float* gate = (const float*)(p.ws + OFF_MOD) + (l * 2 + b) * 3072 + 2048;
#pragma unroll
        for (int j = 0; j < 4; ++j) {
            const int col = n0 + 64 * wn + 16 * j + 4 * fq;
            const f32x4 xo = *(const f32x4*)(xin + (size_t)row * 1024 + col), g = *(const f32x4*)(gate + col);
            f32x4 r;
#pragma unroll
            for (int jj = 0; jj < 4; ++jj) r[jj] = xo[jj] + g[jj] * acc[i][j][jj];
            if (!dry) *(f32x4*)(p.out + (size_t)row * 1024 + col) = r;
        }
    }
}

constexpr int LDS_BYTES = 131072, HALF_LDS = 65536;
constexpr int N_PHASES = 14;
DI void phase_prep(const Params& p, unsigned char* sm) {
    const int bid = blockIdx.x, G = gridDim.x, vb = vb_();
    unsigned char* smv = sm + vb * HALF_LDS;
    if (bid == 0) { const int t = tid8_(); if (t < 256) ((unsigned*)p.ws)[t] = 0u; }
    if (bid == G - 1 && vb == 1) lb_item(p);
#pragma unroll 1
    for (int k = bid; k < 96; k += G) mod_item(p, 2 * k + vb, (float*)smv);
}
DI void phase_final(const Params& p) { for (int it = 2 * blockIdx.x + vb_(); it < 4096; it += 2 * gridDim.x) final_item(p, it); }
template <int SP> DI void layer_phase(const Params& p, int l, unsigned char* sm, int dry, int qidx) {
    const int bid = blockIdx.x, G = gridDim.x, vb = vb_();
    unsigned char* smv = sm + vb * HALF_LDS;
    if (SP == 0) {
#pragma unroll 1
        for (int it = 2 * bid + vb; it < 4096; it += 2 * G) norm_item(p, l, it);
#pragma unroll 1
        for (int k = G - 1 - bid; k < CONV_ITEMS / 2; k += G) conv_weights(p, l, 2 * k + vb, (float*)smv);
    } else if (SP == 1) {
#pragma unroll 1
        for (int q = bid >> 3; q < 8 * INPROJ_NT; q += (G >> 3)) inproj_item(p, 8 * (bid & 7) + (q & 7), q >> 3, sm, dry);
    } else if (SP == 2) {
        const int xcd = bid & 7, nq = G >> 3;
        unsigned* ctr = (unsigned*)p.ws + qidx + xcd * 2;
        int it = bid >> 3;
#pragma unroll 1
        for (;;) {
            if (it >= 88) break;
            if (it < 8) { for (int r = 0; r < REPG2; ++r) gla_item<128, false, false>(p, l, 2 * (xcd * 8 + it) + vb, smv, dry); }
            else if (it < 16) { for (int r = 0; r < REPG2; ++r) gla_item<64, true, false>(p, l, 2 * (xcd * 8 + it - 8) + vb, smv, dry); }
            else if (it < 24) kr_item(p, xcd * 8 + it - 16);
            else if (it < 56) { for (int r = 0; r < REPQ2; ++r) qup_item(p, xcd * 32 + it - 24, (bf16_t*)sm, dry | (r + 1 < REPQ2)); }
            else { const int t = xcd * 32 + it - 56; for (int r = 0; r < REPK2; ++r) kvup_item(p, t >> 2, t & 3, sm); }
            it = nq + grab_item(ctr, sm);
        }
    } else if (SP == 3) {
        const int xcd = bid & 7;
        unsigned* ctr = (unsigned*)p.ws + qidx + xcd * 2;
        int it = bid >> 3;
#pragma unroll 1
        for (;; it = (G >> 3) + grab_item(ctr, sm)) {
            if (it >= 80) break;
            if (it < 8) { for (int r = 0; r < REPG3; ++r) gla_item<128, false, true>(p, l, 2 * (xcd * 8 + it) + vb, smv, dry | (r + 1 < REPG3)); }
            else if (it < 16) { for (int r = 0; r < REPG3; ++r) gla_item<64, true, true>(p, l, 2 * (xcd * 8 + it - 8) + vb, smv, dry | (r + 1 < REPG3)); }
            else { for (int r = 0; r < REPA3; ++r) attn_item(p, 31 - ((it - 16) >> 1), 2 * xcd + ((it - 16) & 1), (bf16_t*)sm, dry | (r + 1 < REPA3)); }
        }
    } else if (SP == 4) {
#pragma unroll 1
        for (int q = bid >> 3; q < 8 * 8; q += (G >> 3)) merge_item(p, 8 * (bid & 7) + (q & 7), q >> 3, sm);
    } else {
#pragma unroll 1
        for (int q = bid >> 3; q < 8 * 4; q += (G >> 3)) out_item(p, l, 8 * (bid & 7) + (q & 7), q >> 3, sm, dry);
    }
}

#if ONE_LAUNCH
__global__ void __launch_bounds__(512, 2) __attribute__((amdgpu_waves_per_eu(2, 2))) fwd_megakernel(Params p) {
    extern __shared__ __attribute__((aligned(1024))) unsigned char sm[];
    cg::grid_group grid = cg::this_grid();
    unsigned* gbar = (unsigned*)(p.ws + OFF_BAR); unsigned gk = 0;
    phase_prep(p, sm); grid.sync();
#define RUN_PH(SP, L, REP) for (int rep = 0; rep < (REP); ++rep) { int dry = (rep + 1 < (REP)) ? 1 : 0; asm volatile("" : "+s"(dry)); layer_phase<SP>(p, L, sm, dry, (L) * 128 + (SP) * 16 + rep); grid_barrier(gbar, ++gk); }
    RUN_PH(0, 0, REP0) RUN_PH(1, 0, REP1) RUN_PH(2, 0, REP2) RUN_PH(3, 0, REP3) RUN_PH(4, 0, REP4) RUN_PH(5, 0, REP5)
    RUN_PH(0, 1, REP0) RUN_PH(1, 1, REP1) RUN_PH(2, 1, REP2) RUN_PH(3, 1, REP3) RUN_PH(4, 1, REP4) RUN_PH(5, 1, REP5)
    phase_final(p);
}
#else
__global__ void __launch_bounds__(512, 2) phase_kernel(Params p, int ph) {
    extern __shared__ __attribute__((aligned(1024))) unsigned char sm[];
    if (ph == 0) { phase_prep(p, sm); return; }
    if (ph == 13) { phase_final(p); return; }
    const int l = (ph - 1) / 6, sp = (ph - 1) % 6;
    if (sp == 0) layer_phase<0>(p, l, sm, 0, l * 128 + 0 * 16); else if (sp == 1) layer_phase<1>(p, l, sm, 0, l * 128 + 1 * 16); else if (sp == 2) layer_phase<2>(p, l, sm, 0, l * 128 + 2 * 16);
    else if (sp == 3) layer_phase<3>(p, l, sm, 0, l * 128 + 3 * 16); else if (sp == 4) layer_phase<4>(p, l, sm, 0, l * 128 + 4 * 16); else layer_phase<5>(p, l, sm, 0, l * 128 + 5 * 16);
}
#endif

extern "C" void kernel_launch(void* const* d_in, const int* in_sizes, int n_in, void* d_out, int out_size, void* d_ws, size_t ws_size, hipStream_t stream) {
    Params p{};
    p.x = (const float*)d_in[0]; p.c = (const float*)d_in[1]; p.pos = (const int*)d_in[2]; p.norm_g = (const float*)d_in[3];
    p.w_mod = (const float*)d_in[4]; p.b_mod = (const float*)d_in[5]; p.w_in = (const float*)d_in[6]; p.hg_lb = (const float*)d_in[7];
    p.hg_onorm = (const float*)d_in[8]; p.g_cq = (const float*)d_in[9]; p.w_uq = (const float*)d_in[10]; p.g_ckv = (const float*)d_in[11];
    p.w_ukv = (const float*)d_in[12]; p.w_pa = (const float*)d_in[13]; p.w_pb = (const float*)d_in[14]; p.w_pc = (const float*)d_in[15];
    p.w_out = (const float*)d_in[16]; p.final_g = (const float*)d_in[17];
    p.out = (float*)d_out; p.ws = (unsigned char*)d_ws;
#if ONE_LAUNCH
    static int grid_blocks = 0;
    if (!grid_blocks) {
        int dev = 0, cus = 0, per_cu = 0;
        (void)hipGetDevice(&dev);
        (void)hipDeviceGetAttribute(&cus, hipDeviceAttributeMultiprocessorCount, dev);
        if (hipFuncSetAttribute((const void*)fwd_megakernel, hipFuncAttributeMaxDynamicSharedMemorySize, LDS_BYTES) != hipSuccess)
            fprintf(stderr, "hipFuncSetAttribute(MaxDynamicSharedMemorySize=%d) failed\n", LDS_BYTES);
        (void)hipOccupancyMaxActiveBlocksPerMultiprocessor(&per_cu, fwd_megakernel, 512, LDS_BYTES);
        if (per_cu < 1) per_cu = 1;
        if (per_cu > 1) per_cu = 1;
        grid_blocks = (cus / 8) * 8 * per_cu;
    }
    (void)hipMemsetAsync((unsigned char*)d_ws + OFF_BAR, 0, BAR_BYTES, stream);
    void* args[] = {&p};
    hipError_t e = hipLaunchCooperativeKernel((void*)fwd_megakernel, dim3(grid_blocks), dim3(512), args, LDS_BYTES, stream);
    if (e != hipSuccess) fprintf(stderr, "cooperative launch failed: %s (grid %d)\n", hipGetErrorString(e), grid_blocks);
#else
    (void)hipFuncSetAttribute((const void*)phase_kernel, hipFuncAttributeMaxDynamicSharedMemorySize, LDS_BYTES);
    for (int ph = 0; ph < N_PHASES; ++ph) phase_kernel<<<256, 512, LDS_BYTES, stream>>>(p, ph);
#endif
}
```

```cpp
#include <hip/hip_runtime.h>
#include <hip/hip_cooperative_groups.h>
#include <cstdio>
#include <cstdint>
namespace cg = cooperative_groups;

#define DI __device__ __forceinline__
typedef unsigned short bf16_t;
typedef short bf16x8 __attribute__((ext_vector_type(8)));
typedef float f32x4 __attribute__((ext_vector_type(4)));
typedef float f32x16 __attribute__((ext_vector_type(16)));
typedef float f32x2 __attribute__((ext_vector_type(2)));
typedef unsigned u32x2 __attribute__((ext_vector_type(2)));
typedef unsigned u32x4 __attribute__((ext_vector_type(4)));
typedef __bf16 bf16x2_t __attribute__((ext_vector_type(2)));

#ifndef ONE_LAUNCH
#define ONE_LAUNCH 1
#endif
#define REP0 1
#define REP1 1
#define REP2 1
#define REP3 1
#define REP4 1
#define REP5 1
#define REPG3 1
#define REPA3 1
#define REPG2 1
#define REPQ2 1
#define REPK2 1

constexpr int SEQ = 8192, NTOK = 16384, DM = 1024;
constexpr int PC = 5152;
constexpr int DIN = 8224;
constexpr int C_HQ = 0, C_HZ = 512, C_HV = 1024, C_HG = 1536, C_CQ = 2048, C_CKV = 2816, C_GB = 3072,
              C_RQ = 3584, C_RK = 3840, C_RV = 4096, C_RG = 4608, C_KR = 5120;
constexpr float EPSF = 1e-6f;
constexpr float LOG2_1E4 = 13.287712379549449f;
constexpr float QSCALE = 0.10206207261596577f * 1.4426950408889634f;

constexpr size_t OFF_MOD = 4096;
constexpr size_t OFF_LB  = OFF_MOD + 2 * 2 * 3072 * 4;
constexpr size_t OFF_SSQ = OFF_LB + 2 * 512 * 4;
constexpr size_t OFF_HGB = OFF_SSQ + 16384 * 2 * 4;
constexpr size_t OFF_HGU = 262144;
constexpr size_t OFF_RTU = OFF_HGU + 128ull * 16384 * 4;
constexpr size_t OFF_WM  = OFF_RTU + 128ull * 8192 * 4;
constexpr size_t OFF_WUQ = OFF_WM + 3072ull * 1024 * 2;
constexpr size_t OFF_WUKV = OFF_WUQ + 768ull * 768 * 2;
constexpr size_t OFF_WP  = OFF_WUKV + 1024ull * 256 * 2;
constexpr size_t OFF_WOUT = OFF_WP + 3ull * 1024 * 512 * 2;
constexpr size_t OFF_H   = OFF_WOUT + 1024ull * 1024 * 2;
constexpr size_t OFF_P   = OFF_H + 16384ull * 1024 * 2;
constexpr size_t OFF_KN  = OFF_P + 16384ull * PC * 2;
constexpr size_t OFF_VT  = OFF_KN + 16384ull * 512 * 2;
constexpr size_t OFF_WKR = OFF_VT + 16384ull * 512 * 2;
constexpr size_t OFF_BAR = OFF_WKR + 32ull * 1024 * 2;
constexpr size_t BAR_BYTES = 8192;
constexpr size_t WS_END  = OFF_BAR + BAR_BYTES;
static_assert(OFF_HGB + 128 * 128 * 4 <= OFF_HGU, "ws map");
static_assert(WS_END <= 268435456ull, "workspace too large");
static_assert(OFF_P % 256 == 0 && OFF_KN % 256 == 0 && OFF_H % 256 == 0, "align");

struct Params {
    const float* x; const float* c; const int* pos; const float* norm_g; const float* w_mod; const float* b_mod; const float* w_in;
    const float* hg_lb; const float* hg_onorm; const float* g_cq; const float* w_uq; const float* g_ckv; const float* w_ukv;
    const float* w_pa; const float* w_pb; const float* w_pc; const float* w_out; const float* final_g;
    float* out; unsigned char* ws;
};


DI float bf2f(bf16_t v) { return __uint_as_float(((unsigned)v) << 16); }
DI unsigned pk2(float lo, float hi) { f32x2 v = {lo, hi}; bf16x2_t b = __builtin_convertvector(v, bf16x2_t); return __builtin_bit_cast(unsigned, b); }
DI bf16_t f2bf(float v) { return (bf16_t)(pk2(v, 0.f) & 0xffffu); }
DI u32x2 pk4(f32x4 v) { u32x2 r; r.x = pk2(v[0], v[1]); r.y = pk2(v[2], v[3]); return r; }
DI f32x4 unpk4(u32x2 u) { f32x4 r; r[0] = __uint_as_float(u.x << 16); r[1] = __uint_as_float(u.x & 0xffff0000u); r[2] = __uint_as_float(u.y << 16); r[3] = __uint_as_float(u.y & 0xffff0000u); return r; }
DI float sigmoidf_(float v) { return __builtin_amdgcn_rcpf(1.f + __builtin_amdgcn_exp2f(-1.4426950408889634f * v)); }
DI float siluf_(float v) { return v * __builtin_amdgcn_rcpf(1.f + __builtin_amdgcn_exp2f(-1.4426950408889634f * v)); }
DI int tid8_() { int t = threadIdx.x; asm volatile("" : "+v"(t)); return t; }
DI int tid_() { return tid8_() & 255; }
DI int vb_() { return __builtin_amdgcn_readfirstlane(tid8_() >> 8); }
DI int grab_item(unsigned* ctr, unsigned char* sm) {
    __syncthreads();
    if (tid8_() == 0) *(volatile int*)sm = (int)atomicAdd(ctr, 1u);
    __syncthreads();
    const int it = *(volatile int*)sm;
    __syncthreads();
    return it;
}
#define GB_GRP(g)  (64u * (1u + (g)))
#define GB_GGEN(g) (64u * (9u + (g)))
#define GB_TOP     (64u * 17u)
#define GB_TOPGEN  (64u * 18u)
DI unsigned gb_ld(unsigned* p) { return __hip_atomic_load(p, __ATOMIC_RELAXED, __HIP_MEMORY_SCOPE_AGENT); }
DI unsigned gb_add(unsigned* p) { return __hip_atomic_fetch_add(p, 1u, __ATOMIC_RELAXED, __HIP_MEMORY_SCOPE_AGENT); }
DI void grid_barrier(unsigned* bar, unsigned k) {
    asm volatile("s_waitcnt vmcnt(0)" ::: "memory");
    __syncthreads();
    if (tid8_() == 0) {
        const unsigned g = blockIdx.x & 7u, nloc = gridDim.x >> 3;
        __builtin_amdgcn_fence(__ATOMIC_RELEASE, "agent");
        asm volatile("s_waitcnt vmcnt(0)" ::: "memory");
        const unsigned old = gb_add(&bar[GB_GRP(g)]);
        if (old + 1u == k * nloc) {
            const unsigned og = gb_add(&bar[GB_TOP]);
            if (og + 1u == k * 8u) gb_add(&bar[GB_TOPGEN]);
            else while (gb_ld(&bar[GB_TOPGEN]) < k) __builtin_amdgcn_s_sleep(1);
            gb_add(&bar[GB_GGEN(g)]);
        } else {
            while (gb_ld(&bar[GB_GGEN(g)]) < k) __builtin_amdgcn_s_sleep(2);
        }
        __builtin_amdgcn_fence(__ATOMIC_ACQUIRE, "agent");
        asm volatile("s_waitcnt vmcnt(0)" ::: "memory");
    }
    __syncthreads();
}
DI int crow(int i, int hh) { return (i & 3) + 8 * (i >> 2) + 4 * hh; }
DI f32x16 mfma32(bf16x8 a, bf16x8 b, f32x16 c) { return __builtin_amdgcn_mfma_f32_32x32x16_bf16(a, b, c, 0, 0, 0); }
DI f32x4 mfma16(bf16x8 a, bf16x8 b, f32x4 c) { return __builtin_amdgcn_mfma_f32_16x16x32_bf16(a, b, c, 0, 0, 0); }
DI bf16x8 pack8(float a0, float a1, float a2, float a3, float a4, float a5, float a6, float a7) {
    u32x4 u; u.x = pk2(a0, a1); u.y = pk2(a2, a3); u.z = pk2(a4, a5); u.w = pk2(a6, a7); return __builtin_bit_cast(bf16x8, u);
}
DI bf16x8 join8(u32x2 lo, u32x2 hi) { u32x4 u; u.x = lo.x; u.y = lo.y; u.z = hi.x; u.w = hi.y; return __builtin_bit_cast(bf16x8, u); }
DI float warp_sum(float v) {
#pragma unroll
    for (int o = 32; o > 0; o >>= 1) v += __shfl_xor(v, o);
    return v;
}
DI void rope2(float& a, float& b, float ang) {
    const float n = rintf(ang * 0.15915493667125702f);
    float r = __builtin_fmaf(ang, 0.15915493667125702f, -n);
    r = __builtin_fmaf(ang, 6.4206382432985265e-09f, r);
    const float s = __builtin_amdgcn_sinf(r), c = __builtin_amdgcn_cosf(r);
    const float x1 = a, x2 = b; a = x1 * c - x2 * s; b = x2 * c + x1 * s;
}

DI int perm32(int rho) { return 8 * ((rho & 15) >> 2) + 4 * (rho >> 4) + (rho & 3); }
template <bool FRAG = false, bool PERM = false>
DI void conv_tile(const float* __restrict__ src, int ldsrc, int srccol0, int k0, bf16_t* dst, int lddst, int n0,
                  const float* __restrict__ rowscale, float sc, float* sm) {
    const int tid = tid_(), nn = tid & 31, kk0 = tid >> 5;
#pragma unroll 4
    for (int i = 0; i < 16; ++i) {
        const int kk = kk0 + 8 * i;
        float v = src[(size_t)(k0 + kk) * ldsrc + srccol0 + nn];
        if (rowscale) v *= rowscale[k0 + kk];
        sm[kk * 33 + nn] = v * sc;
    }
    __syncthreads();
    const int kp = 2 * (tid & 63), nb = tid >> 6;
#pragma unroll
    for (int i = 0; i < 8; ++i) {
        const int n = nb + 4 * i;
        const int ng = n0 + n, kg = k0 + kp;
        const size_t off = FRAG ? ((size_t)((ng >> 4) * (lddst >> 5) + (kg >> 5)) * 512 + (((ng & 15) + 16 * ((kg >> 3) & 3)) << 3) + (kg & 7)) : ((size_t)ng * lddst + kg);
        const int ns = PERM ? perm32(n) : n;
        *(unsigned*)(dst + off) = pk2(sm[kp * 33 + ns], sm[(kp + 1) * 33 + ns]);
    }
    __syncthreads();
}

constexpr int CONV_ITEMS = 1288 + 768 + 144 + 64 + 384 + 256;
DI void conv_weights(const Params& p, int l, int item, float* sm) {
    unsigned char* ws = p.ws;
    const float* w_in = p.w_in + (size_t)l * 1024 * DIN;
    if (item < 1288) { const int n0 = (item >> 3) * 32, kb = item & 7; const int sc0 = n0 < 3072 ? n0 : (n0 < 5120 ? n0 + 32 : 3072);
        if (n0 >= 5120) conv_tile(w_in, DIN, sc0, kb * 128, (bf16_t*)(ws + OFF_WKR), 1024, n0 - 5120, nullptr, 1.f, sm);
        else conv_tile<false, true>(w_in, DIN, sc0, kb * 128, (bf16_t*)(ws + OFF_KN), 1024, n0, nullptr, 1.f, sm);
        return; }
    item -= 1288;
    if (item < 768) { const int n0 = (item >> 3) * 32, kb = item & 7;
        conv_tile<false, true>(w_in, DIN, 5152 + n0, kb * 128, (bf16_t*)(ws + OFF_WM), 1024, n0, nullptr, 1.f, sm); return; }
    item -= 768;
    if (item < 144) { const int n0 = (item / 6) * 32, kb = item % 6; const int sc0 = n0 < 512 ? (n0 >> 6) * 96 + (n0 & 63) : ((n0 - 512) >> 5) * 96 + 64;
        conv_tile<true>(p.w_uq + (size_t)l * 768 * 768, 768, sc0, kb * 128, (bf16_t*)(ws + OFF_WUQ), 768, n0, p.g_cq + l * 768, QSCALE, sm); return; }
    item -= 144;
    if (item < 64) { const int n0 = (item >> 1) * 32, kb = item & 1;
        conv_tile<false, true>(p.w_ukv + (size_t)l * 256 * 1024, 1024, n0, kb * 128, (bf16_t*)(ws + OFF_WUKV), 256, n0, p.g_ckv + l * 256, 1.f, sm); return; }
    item -= 64;
    if (item < 384) { const int br = item >> 7, r = item & 127, n0 = (r >> 2) * 32, kb = r & 3;
        const float* w = (br == 0 ? p.w_pa : (br == 1 ? p.w_pb : p.w_pc)) + (size_t)l * 512 * 1024;
        conv_tile<false, true>(w, 1024, n0, kb * 128, (bf16_t*)(ws + OFF_WP) + (size_t)br * 1024 * 512, 512, n0, nullptr, 1.f, sm); return; }
    item -= 384;
    { const int n0 = (item >> 3) * 32, kb = item & 7;
        conv_tile(p.w_out + (size_t)l * 1024 * 1024, 1024, n0, kb * 128, (bf16_t*)(ws + OFF_WOUT), 1024, n0, nullptr, 1.f, sm); }
}

DI void mod_item(const Params& p, int item, float* sm) {
    const int l = item / 96, n0 = (item % 96) * 32, tid = tid_(), nn = tid & 31, ks = tid >> 5;
    float* sc = sm + 1024;
    for (int e = tid; e < 2048; e += 256) sc[e] = siluf_(p.c[e]);
    __syncthreads();
    const float* w = p.w_mod + (size_t)l * 1024 * 3072 + n0 + nn + (size_t)(ks * 128) * 3072;
    float s0 = 0.f, s1 = 0.f;
#pragma unroll 1
    for (int k0 = 0; k0 < 128; k0 += 16) {
        float wv[16];
#pragma unroll
        for (int u = 0; u < 16; ++u) wv[u] = w[(size_t)(k0 + u) * 3072];
#pragma unroll
        for (int u = 0; u < 16; ++u) { s0 += sc[ks * 128 + k0 + u] * wv[u]; s1 += sc[1024 + ks * 128 + k0 + u] * wv[u]; }
    }
    sm[(ks * 32 + nn) * 2] = s0; sm[(ks * 32 + nn) * 2 + 1] = s1;
    __syncthreads();
    if (tid < 64) { const int n = tid & 31, b = tid >> 5; float s = 0.f;
        for (int q = 0; q < 8; ++q) s += sm[(q * 32 + n) * 2 + b];
        ((float*)(p.ws + OFF_MOD))[(l * 2 + b) * 3072 + n0 + n] = s + p.b_mod[l * 3072 + n0 + n]; }
    __syncthreads();
}
DI void lb_item(const Params& p) {
    float* LB = (float*)(p.ws + OFF_LB);
    for (int ch = tid_(); ch < 512; ch += 256) {
        const float l0 = p.hg_lb[ch], l1 = p.hg_lb[512 + ch];
        LB[ch] = 0.f; LB[512 + ch] = 1.f / (1.f + expf(l0 - l1));
    }
}

DI void norm_item(const Params& p, int l, int item) {
    const int tid__ = tid_(), lane = tid__ & 63, row = item * 4 + (tid__ >> 6), b = row >> 13;
    const float* xin = (l == 0 ? p.x : p.out) + (size_t)row * 1024;
    f32x4 v[4]; float ss = 0.f;
#pragma unroll
    for (int i = 0; i < 4; ++i) { v[i] = *(const f32x4*)(xin + lane * 4 + 256 * i); ss += v[i][0] * v[i][0] + v[i][1] * v[i][1] + v[i][2] * v[i][2] + v[i][3] * v[i][3]; }
    ss = warp_sum(ss);
    const float rstd = rsqrtf(ss * (1.f / 1024.f) + EPSF);
    const float* mod = (const float*)(p.ws + OFF_MOD) + (l * 2 + b) * 3072;
    bf16_t* h = (bf16_t*)(p.ws + OFF_H) + (size_t)row * 1024;
#pragma unroll
    for (int i = 0; i < 4; ++i) {
        const int col = lane * 4 + 256 * i;
        const f32x4 g = *(const f32x4*)(p.norm_g + l * 1024 + col), sh = *(const f32x4*)(mod + col), sc = *(const f32x4*)(mod + 1024 + col);
        f32x4 o;
#pragma unroll
        for (int j = 0; j < 4; ++j) o[j] = v[i][j] * rstd * g[j] * (1.f + sc[j]) + sh[j];
        *(u32x2*)(h + col) = pk4(o);
    }
    if (lane == 0) { float* ssq = (float*)(p.ws + OFF_SSQ) + row * 2; ssq[0] = 0.f; ssq[1] = 0.f; }
}
DI void final_item(const Params& p, int item) {
    const int tid__ = tid_(), lane = tid__ & 63, row = item * 4 + (tid__ >> 6);
    float* xr = p.out + (size_t)row * 1024;
    f32x4 v[4]; float ss = 0.f;
#pragma unroll
    for (int i = 0; i < 4; ++i) { v[i] = *(const f32x4*)(xr + lane * 4 + 256 * i); ss += v[i][0] * v[i][0] + v[i][1] * v[i][1] + v[i][2] * v[i][2] + v[i][3] * v[i][3]; }
    ss = warp_sum(ss);
    const float rstd = rsqrtf(ss * (1.f / 1024.f) + EPSF);
#pragma unroll
    for (int i = 0; i < 4; ++i) {
        const int col = lane * 4 + 256 * i; const f32x4 g = *(const f32x4*)(p.final_g + col);
        f32x4 o;
#pragma unroll
        for (int j = 0; j < 4; ++j) o[j] = v[i][j] * rstd * g[j];
        *(f32x4*)(xr + col) = o;
    }
}

template <int MT, int NT, int WN>
DI void gemm8(const bf16_t* A, int lda, const bf16_t* Bt, int ldb, int K, f32x4 (&acc)[MT][NT], unsigned char* smb) {
    constexpr int WM = 8 / WN, BM = 16 * MT * WM, BN = 16 * NT * WN;
    static_assert(BM == 256, "block tile is 256 rows");
    constexpr int A_B = BM * 128, B_B = BN * 128, ST_B = A_B + B_B, NA = BM / 64, NB = BN / 64;
    const int tid = tid8_(), lane = tid & 63, wave = tid >> 6, wm = wave / WN, wn = wave % WN;
    const int fr = lane & 15, fq = lane >> 4, lr = lane >> 3, pc = lane & 7;
    const bf16_t* ag[NA]; const bf16_t* bg[NB];
#pragma unroll
    for (int i = 0; i < NA; ++i) { const int row = 8 * (8 * i + wave) + lr, c = pc ^ ((row >> 1) & 7); ag[i] = A + (size_t)row * lda + c * 8; }
#pragma unroll
    for (int i = 0; i < NB; ++i) { const int row = 8 * (8 * i + wave) + lr, c = pc ^ ((row >> 1) & 7); bg[i] = Bt + (size_t)row * ldb + c * 8; }
    auto stage = [&](int buf, int ko) {
#pragma unroll
        for (int i = 0; i < NA; ++i) __builtin_amdgcn_global_load_lds((const unsigned*)(ag[i] + ko), (unsigned*)(smb + buf * ST_B + (8 * i + wave) * 1024), 16, 0, 0);
#pragma unroll
        for (int i = 0; i < NB; ++i) __builtin_amdgcn_global_load_lds((const unsigned*)(bg[i] + ko), (unsigned*)(smb + buf * ST_B + A_B + (8 * i + wave) * 1024), 16, 0, 0);
    };
    const int KT = K >> 6;
    const int swz = fr >> 1;
    const int aoff = (16 * MT * wm + fr) * 128, boff = A_B + (16 * NT * wn + fr) * 128;
    stage(0, 0);
    asm volatile("s_waitcnt vmcnt(0)" ::: "memory");
    __syncthreads();
#pragma unroll 1
    for (int kt = 0; kt < KT; ++kt) {
        const int cur = kt & 1;
        if (kt + 1 < KT) stage(cur ^ 1, (kt + 1) * 64);
        const unsigned char* sb = smb + cur * ST_B;
#pragma unroll
        for (int ks = 0; ks < 2; ++ks) {
            const int co = ((4 * ks + fq) ^ swz) << 4;
            bf16x8 af[MT], bf[NT];
#pragma unroll
            for (int i = 0; i < MT; ++i) af[i] = *(const bf16x8*)(sb + aoff + i * 2048 + co);
#pragma unroll
            for (int j = 0; j < NT; ++j) bf[j] = *(const bf16x8*)(sb + boff + j * 2048 + co);
#pragma unroll
            for (int i = 0; i < MT; ++i)
#pragma unroll
                for (int j = 0; j < NT; ++j) acc[i][j] = mfma16(bf[j], af[i], acc[i][j]);
        }
        asm volatile("s_waitcnt vmcnt(0)" ::: "memory");
        __syncthreads();
    }
}
template <int MT, int NT> DI void zero_acc(f32x4 (&acc)[MT][NT]) {
#pragma unroll
    for (int i = 0; i < MT; ++i)
#pragma unroll
        for (int j = 0; j < NT; ++j) acc[i][j] = (f32x4){0.f, 0.f, 0.f, 0.f};
}

constexpr int INPROJ_NT = 20;
DI void inproj_item(const Params& p, int mt, int nt, unsigned char* smb, int dry) {
    const int m0 = mt * 256, n0 = nt * 256;
    f32x4 acc[8][4]; zero_acc<8, 4>(acc);
    gemm8<8, 4, 4>((const bf16_t*)(p.ws + OFF_H) + (size_t)m0 * 1024, 1024, (const bf16_t*)(p.ws + OFF_KN) + (size_t)n0 * 1024, 1024, 1024, acc, smb);
    const int tid = tid8_(), lane = tid & 63, wave = tid >> 6, wm = wave >> 2, wn = wave & 3, fr = lane & 15, fq = lane >> 4;
    const int cb = n0 + 64 * wn;
    bf16_t* P = (bf16_t*)(p.ws + OFF_P);
    const int rbase = m0 + 128 * wm + fr;
    if (cb >= C_RQ && cb < C_RV) {
        const float sc = cb >= C_RK ? 0.125f : 1.f;
#pragma unroll
        for (int i = 0; i < 8; ++i) {
            const int row = rbase + 16 * i; const float pos = (float)p.pos[row];
#pragma unroll
            for (int j = 0; j < 2; ++j)
#pragma unroll
                for (int jj = 0; jj < 4; ++jj) {
                    const int d = 8 * fq + 4 * j + jj; const float inv = exp2f(-(float)d * (LOG2_1E4 / 32.f));
                    float a = acc[i][j][jj], b = acc[i][j + 2][jj]; rope2(a, b, pos * inv); acc[i][j][jj] = a * sc; acc[i][j + 2][jj] = b * sc;
                }
#pragma unroll
            for (int g = 0; g < 2; ++g) { const u32x2 lo = pk4(acc[i][2 * g]), hi = pk4(acc[i][2 * g + 1]);
                *(u32x4*)(P + (size_t)row * PC + cb + 32 * g + 8 * fq) = (u32x4){lo.x, lo.y, hi.x, hi.y}; }
        }
    } else {
        const bool is_silu = (cb >= C_HG && cb < C_CQ) || (cb >= C_GB && cb < C_RQ) || (cb >= C_RG && cb < C_KR);
        const bool is_hq = cb < C_HZ;
        const bool is_cq = cb >= C_CQ && cb < C_CKV, is_ckv = cb >= C_CKV && cb < C_GB;
#pragma unroll
        for (int i = 0; i < 8; ++i) {
            const int row = rbase + 16 * i;
            if (is_cq || is_ckv) {
                float s = 0.f;
#pragma unroll
                for (int j = 0; j < 4; ++j) s += acc[i][j][0] * acc[i][j][0] + acc[i][j][1] * acc[i][j][1] + acc[i][j][2] * acc[i][j][2] + acc[i][j][3] * acc[i][j][3];
                s += __shfl_xor(s, 16); s += __shfl_xor(s, 32);
                if (fq == 0 && !dry) atomicAdd((float*)(p.ws + OFF_SSQ) + row * 2 + (is_ckv ? 1 : 0), s);
            }
#pragma unroll
            for (int g = 0; g < 2; ++g) {
                f32x4 v0 = acc[i][2 * g], v1 = acc[i][2 * g + 1];
                if (is_silu) {
#pragma unroll
                    for (int jj = 0; jj < 4; ++jj) { v0[jj] = siluf_(v0[jj]); v1[jj] = siluf_(v1[jj]); }
                } else if (is_hq) {
#pragma unroll
                    for (int jj = 0; jj < 4; ++jj) { v0[jj] = siluf_(v0[jj]) * 0.08838834764831845f; v1[jj] = siluf_(v1[jj]) * 0.08838834764831845f; }
                }
                const u32x2 lo = pk4(v0), hi = pk4(v1);
                *(u32x4*)(P + (size_t)row * PC + cb + 32 * g + 8 * fq) = (u32x4){lo.x, lo.y, hi.x, hi.y};
            }
        }
    }
}

DI void kr_item(const Params& p, int item) {
    const int tid = tid8_(), lane = tid & 63, wave = tid >> 6, fr = lane & 15, fq = lane >> 4;
    const int r0 = item * 256 + 32 * wave;
    const bf16_t* ap = (const bf16_t*)(p.ws + OFF_H) + (size_t)(r0 + fr) * 1024 + 8 * fq;
    const bf16_t* bp = (const bf16_t*)(p.ws + OFF_WKR) + (size_t)fr * 1024 + 8 * fq;
    f32x4 acc[2][2];
#pragma unroll
    for (int i = 0; i < 2; ++i)
#pragma unroll
        for (int j = 0; j < 2; ++j) acc[i][j] = (f32x4){0.f, 0.f, 0.f, 0.f};
#pragma unroll 4
    for (int ks = 0; ks < 32; ++ks) {
        const bf16x8 a0 = *(const bf16x8*)(ap + 32 * ks), a1 = *(const bf16x8*)(ap + 16 * 1024 + 32 * ks);
        const bf16x8 b0 = *(const bf16x8*)(bp + 32 * ks), b1 = *(const bf16x8*)(bp + 16 * 1024 + 32 * ks);
        acc[0][0] = mfma16(b0, a0, acc[0][0]); acc[0][1] = mfma16(b1, a0, acc[0][1]);
        acc[1][0] = mfma16(b0, a1, acc[1][0]); acc[1][1] = mfma16(b1, a1, acc[1][1]);
    }
    bf16_t* P = (bf16_t*)(p.ws + OFF_P);
#pragma unroll
    for (int i = 0; i < 2; ++i) {
        const int row = r0 + 16 * i + fr; const float pos = (float)p.pos[row];
#pragma unroll
        for (int jj = 0; jj < 4; ++jj) {
            const int d = 4 * fq + jj; const float inv = exp2f(-(float)d * (LOG2_1E4 / 16.f));
            float a = acc[i][0][jj], b = acc[i][1][jj]; rope2(a, b, pos * inv); acc[i][0][jj] = a; acc[i][1][jj] = b;
        }
#pragma unroll
        for (int j = 0; j < 2; ++j) *(u32x2*)(P + (size_t)row * PC + C_KR + 16 * j + 4 * fq) = pk4(acc[i][j]);
    }
}

DI void kvup_item(const Params& p, int mt, int nt, unsigned char* smb) {
    const int m0 = mt * 256, n0 = nt * 256;
    f32x4 acc[8][4]; zero_acc<8, 4>(acc);
    gemm8<8, 4, 4>((const bf16_t*)(p.ws + OFF_P) + (size_t)m0 * PC + C_CKV, PC, (const bf16_t*)(p.ws + OFF_WUKV) + (size_t)n0 * 256, 256, 256, acc, smb);
    const int tid = tid8_(), lane = tid & 63, wave = tid >> 6, wm = wave >> 2, wn = wave & 3, fr = lane & 15, fq = lane >> 4;
    const int cs = n0 + 64 * wn, head = cs >> 7, isv = (cs >> 6) & 1;
    bf16_t* KN = (bf16_t*)(p.ws + OFF_KN); bf16_t* VT = (bf16_t*)(p.ws + OFF_VT);
    const float* ssq = (const float*)(p.ws + OFF_SSQ);
#pragma unroll
    for (int i = 0; i < 8; ++i) {
        const int row = m0 + 128 * wm + 16 * i + fr;
        const float rstd = rsqrtf(ssq[row * 2 + 1] * (1.f / 256.f) + EPSF);
#pragma unroll
        for (int g = 0; g < 2; ++g) {
            const f32x4 v0 = acc[i][2 * g] * rstd, v1 = acc[i][2 * g + 1] * rstd; const int w = 32 * g + 8 * fq;
            if (!isv) { const u32x2 lo = pk4(v0), hi = pk4(v1); *(u32x4*)(KN + (size_t)row * 512 + head * 64 + w) = (u32x4){lo.x, lo.y, hi.x, hi.y}; }
            else { const int b = row >> 13, t = row & 8191;
#pragma unroll
                for (int jj = 0; jj < 4; ++jj) { VT[((size_t)((b * 8 + head) * 64 + w + jj)) * SEQ + t] = f2bf(v0[jj]); VT[((size_t)((b * 8 + head) * 64 + w + 4 + jj)) * SEQ + t] = f2bf(v1[jj]); } }
        }
    }
}

DI void qup_item(const Params& p, int item, bf16_t* sm, int dry) {
    const int m0 = item * 64, tid = tid8_(), lane = tid & 63, wave = tid >> 6, fr = lane & 15, fq = lane >> 4;
    bf16_t* P = (bf16_t*)(p.ws + OFF_P);
    constexpr int AP = 776;
#pragma unroll
    for (int i = 0; i < 12; ++i) { const int c = tid + 512 * i, r = c / 96, cc = c % 96;
        *(u32x4*)(sm + r * AP + cc * 8) = *(const u32x4*)(P + (size_t)(m0 + r) * PC + C_CQ + cc * 8); }
    __syncthreads();
    const bf16_t* W = (const bf16_t*)(p.ws + OFF_WUQ);
    const int nc0 = 96 * wave;
    f32x4 acc[4][6];
#pragma unroll
    for (int i = 0; i < 4; ++i)
#pragma unroll
        for (int j = 0; j < 6; ++j) acc[i][j] = (f32x4){0.f, 0.f, 0.f, 0.f};
    const bf16_t* wp = W + (size_t)(nc0 >> 4) * 24 * 512 + lane * 8;
    bf16x8 bq[3][6];
#pragma unroll
    for (int u = 0; u < 3; ++u)
#pragma unroll
        for (int j = 0; j < 6; ++j) bq[u][j] = *(const bf16x8*)(wp + (size_t)(j * 24 + u) * 512);
#pragma unroll 1
    for (int ks0 = 0; ks0 < 24; ks0 += 3) {
#pragma unroll
        for (int u = 0; u < 3; ++u) {
            const int ks = ks0 + u;
            bf16x8 af[4];
#pragma unroll
            for (int i = 0; i < 4; ++i) af[i] = *(const bf16x8*)(sm + (16 * i + fr) * AP + 32 * ks + 8 * fq);
#pragma unroll
            for (int j = 0; j < 6; ++j) {
#pragma unroll
                for (int i = 0; i < 4; ++i) acc[i][j] = mfma16(bq[u][j], af[i], acc[i][j]);
            }
            if (ks + 3 < 24) {
#pragma unroll
                for (int j = 0; j < 6; ++j) bq[u][j] = *(const bf16x8*)(wp + (size_t)(j * 24 + ks + 3) * 512);
            }
        }
    }
    const float* ssq = (const float*)(p.ws + OFF_SSQ);
#pragma unroll
    for (int i = 0; i < 4; ++i) {
        const int row = m0 + 16 * i + fr; const float rstd = rsqrtf(ssq[row * 2] * (1.f / 768.f) + EPSF); const float pos = (float)p.pos[row];
#pragma unroll
        for (int j = 0; j < 6; j += 2) {
            f32x4 a = acc[i][j] * rstd, b = acc[i][j + 1] * rstd; const int col = nc0 + 16 * j;
            if (col >= 512) {
#pragma unroll
                for (int jj = 0; jj < 4; ++jj) { const int d = 4 * fq + jj; const float inv = exp2f(-(float)d * (LOG2_1E4 / 16.f)); float x1 = a[jj], x2 = b[jj]; rope2(x1, x2, pos * inv); a[jj] = x1; b[jj] = x2; }
            }
            if (!dry) { *(u32x2*)(P + (size_t)row * PC + C_CQ + col + 4 * fq) = pk4(a);
            *(u32x2*)(P + (size_t)row * PC + C_CQ + col + 16 + 4 * fq) = pk4(b); }
        }
    }
    __syncthreads();
}

DI void attn_item(const Params& p, int qt, int bh, bf16_t* sm, int dry) {
    const int b = bh >> 3, h = bh & 7;
    const int tid = tid8_(), lane = tid & 63, wave = tid >> 6, ql = lane & 31, hh = lane >> 5;
    const int q0 = qt * 256, tokbase = b * SEQ;
    bf16_t* P = (bf16_t*)(p.ws + OFF_P);
    const bf16_t* KN = (const bf16_t*)(p.ws + OFF_KN); const bf16_t* VT = (const bf16_t*)(p.ws + OFF_VT) + (size_t)((b * 8 + h) * 64) * SEQ;
    const int qrow = tokbase + q0 + 32 * wave + ql;
    bf16x8 qf[6];
    { const bf16_t* qp = P + (size_t)qrow * PC + C_CQ;
#pragma unroll
      for (int ks = 0; ks < 4; ++ks) qf[ks] = *(const bf16x8*)(qp + h * 64 + 16 * ks + 8 * hh);
#pragma unroll
      for (int ks = 0; ks < 2; ++ks) qf[4 + ks] = *(const bf16x8*)(qp + 512 + h * 32 + 16 * ks + 8 * hh); }
    constexpr int KP = 104, VP = 136, KSZ = 128 * KP, VSZ = 64 * VP;
    bf16_t* Ks = sm; bf16_t* Vs = sm + 2 * KSZ;
    f32x16 o[2];
#pragma unroll
    for (int i = 0; i < 16; ++i) { o[0][i] = 0.f; o[1][i] = 0.f; }
    float mrun = 0.f, lsum = 0.f;
    const int nkt = 2 * qt + 2;
    const int qg = q0 + 32 * wave + ql;
    u32x4 rk[3], rv[2];
    auto gload = [&](int kt) {
        const int k0 = tokbase + kt * 128;
#pragma unroll
        for (int i = 0; i < 3; ++i) {
            const int c = tid + 512 * i, key = c / 12, cc = c % 12, tok = k0 + key;
            rk[i] = *(const u32x4*)(cc < 8 ? KN + (size_t)tok * 512 + h * 64 + cc * 8 : P + (size_t)tok * PC + C_KR + (cc - 8) * 8);
        }
#pragma unroll
        for (int i = 0; i < 2; ++i) { const int c = tid + 512 * i; rv[i] = *(const u32x4*)(VT + (size_t)(c >> 4) * SEQ + kt * 128 + (c & 15) * 8); }
    };
    gload(0);
#pragma unroll 1
    for (int kt = 0; kt < nkt; ++kt) {
        const int buf = kt & 1;
        bf16_t* Kb = Ks + buf * KSZ; bf16_t* Vb = Vs + buf * VSZ;
#pragma unroll
        for (int i = 0; i < 3; ++i) { const int c = tid + 512 * i; *(u32x4*)(Kb + (c / 12) * KP + (c % 12) * 8) = rk[i]; }
#pragma unroll
        for (int i = 0; i < 2; ++i) { const int c = tid + 512 * i; *(u32x4*)(Vb + (c >> 4) * VP + (c & 15) * 8) = rv[i]; }
        __syncthreads();
        if (kt + 1 < nkt) gload(kt + 1);
        f32x16 s[4];
        __builtin_amdgcn_s_setprio(1);
        {
#pragma unroll
            for (int sub = 0; sub < 4; ++sub)
#pragma unroll
                for (int i = 0; i < 16; ++i) s[sub][i] = -mrun;
#pragma unroll
            for (int sub = 0; sub < 4; ++sub)
#pragma unroll
                for (int ks = 0; ks < 6; ++ks) {
                    const bf16x8 kf = *(const bf16x8*)(Kb + (32 * sub + ql) * KP + 16 * ks + 8 * hh);
                    s[sub] = mfma32(kf, qf[ks], s[sub]);
                }
            __builtin_amdgcn_sched_group_barrier(0x100, 8, 0);
#pragma unroll
            for (int u = 0; u < 16; ++u) { __builtin_amdgcn_sched_group_barrier(0x008, 1, 0); __builtin_amdgcn_sched_group_barrier(0x100, 1, 0); }
            __builtin_amdgcn_sched_group_barrier(0x008, 8, 0);
        }
        __builtin_amdgcn_s_setprio(0);
        if (kt >= nkt - 2) {
#pragma unroll
            for (int sub = 0; sub < 4; ++sub)
#pragma unroll
                for (int i = 0; i < 16; ++i) { const int kg = kt * 128 + 32 * sub + crow(i, hh); if (kg > qg) s[sub][i] = -1e30f; }
        }
        float mx = s[0][0];
#pragma unroll
        for (int sub = 0; sub < 4; ++sub)
#pragma unroll
            for (int i = 0; i < 16; ++i) mx = fmaxf(mx, s[sub][i]);
        mx = fmaxf(mx, __shfl_xor(mx, 32));
        if (__builtin_amdgcn_ballot_w64(mx > 0.f) != 0) {
            const float delta = fmaxf(mx, 0.f), alpha = __builtin_amdgcn_exp2f(-delta);
            mrun += delta; lsum *= alpha;
#pragma unroll
            for (int i = 0; i < 16; ++i) { s[0][i] -= delta; s[1][i] -= delta; s[2][i] -= delta; s[3][i] -= delta; o[0][i] *= alpha; o[1][i] *= alpha; }
        }
        f32x2 rs2 = {0.f, 0.f};
#pragma unroll
        for (int sub = 0; sub < 4; ++sub)
#pragma unroll
            for (int i = 0; i < 16; i += 2) {
                s[sub][i] = __builtin_amdgcn_exp2f(s[sub][i]); s[sub][i + 1] = __builtin_amdgcn_exp2f(s[sub][i + 1]);
                rs2 += (f32x2){s[sub][i], s[sub][i + 1]};
            }
        lsum += rs2[0] + rs2[1];
#pragma unroll
        for (int sub = 0; sub < 4; ++sub)
#pragma unroll
            for (int s2 = 0; s2 < 2; ++s2) {
                const bf16x8 pf = pack8(s[sub][8 * s2], s[sub][8 * s2 + 1], s[sub][8 * s2 + 2], s[sub][8 * s2 + 3], s[sub][8 * s2 + 4], s[sub][8 * s2 + 5], s[sub][8 * s2 + 6], s[sub][8 * s2 + 7]);
#pragma unroll
                for (int dt = 0; dt < 2; ++dt) {
                    const bf16_t* vp = Vb + (32 * dt + ql) * VP + 32 * sub + 16 * s2 + 4 * hh;
                    const bf16x8 vf = join8(*(const u32x2*)vp, *(const u32x2*)(vp + 8));
                    o[dt] = mfma32(vf, pf, o[dt]);
                }
            }
        __builtin_amdgcn_sched_group_barrier(0x100, 4, 1);
#pragma unroll
        for (int u = 0; u < 12; ++u) { __builtin_amdgcn_sched_group_barrier(0x008, 1, 1); __builtin_amdgcn_sched_group_barrier(0x100, 1, 1); }
        __builtin_amdgcn_sched_group_barrier(0x008, 4, 1);
    }
    lsum += __shfl_xor(lsum, 32);
    const float inv = 1.f / lsum;
    bf16_t* gp = P + (size_t)qrow * PC + C_GB + h * 64;
#pragma unroll
    for (int dt = 0; dt < 2; ++dt)
#pragma unroll
        for (int g = 0; g < 4; ++g) {
            const int dv = 32 * dt + 8 * g + 4 * hh;
            const f32x4 gate = unpk4(*(const u32x2*)(gp + dv));
            f32x4 y;
#pragma unroll
            for (int jj = 0; jj < 4; ++jj) y[jj] = o[dt][4 * g + jj] * inv * gate[jj];
            if (!dry) *(u32x2*)(gp + dv) = pk4(y);
        }
    __syncthreads();
}

template <int DK, bool RET, bool OUT>
DI void gla_item(const Params& p, int l, int item, unsigned char* smraw, int dry) {
    constexpr int NT = DK / 32, NP = 256 / DK, TP = 32 / NP, PQ = DK + 8, PT = 40;
    const int b = item >> 6, h = (item >> 4) & 3, seg = item & 15;
    const int tid = tid_(), lane = tid & 63, wave = tid >> 6, ql = lane & 31, hh = lane >> 5;
    bf16_t* Qt = (bf16_t*)smraw; bf16_t* Qh = Qt + 32 * PQ; bf16_t* Kt = Qh + 32 * PQ; bf16_t* KhT = Kt + 32 * PQ; bf16_t* VTs = KhT + DK * PT;
    float* tots = (float*)(VTs + 128 * PT); float* decs = tots + NP * DK; float* sums = decs + DK;
    bf16_t* P = (bf16_t*)(p.ws + OFF_P);
    const int tok0 = b * SEQ + seg * 512;
    const int qcol = RET ? C_RQ + h * 64 : C_HQ + h * 128, kcol = RET ? C_RK + h * 64 : C_HZ + h * 128;
    const int vcol = (RET ? C_RV : C_HV) + h * 128, gcol = (RET ? C_RG : C_HG) + h * 128;
    float* U = (float*)(p.ws + (RET ? OFF_RTU : OFF_HGU)); constexpr int USZ = DK * 128;
    float* HB = (float*)(p.ws + OFF_HGB);
    const float lgam = log1pf(-exp2f(-5.f - (float)h));
    f32x16 S[NT];
#pragma unroll
    for (int t = 0; t < NT; ++t)
#pragma unroll
        for (int i = 0; i < 16; ++i) S[t][i] = 0.f;
    if (OUT) {
        float* dall = (float*)smraw;
        if (!RET) {
            for (int e = tid; e < seg * 128; e += 256) dall[e] = __expf(HB[(item - seg) * 128 + e]);
            __syncthreads();
        }
        const float rdec = __expf(512.f * lgam);
#pragma unroll 2
        for (int m = 0; m < seg; ++m) {
            const int it2 = item - seg + m;
#pragma unroll
            for (int t = 0; t < NT; ++t)
#pragma unroll
                for (int i = 0; i < 16; ++i) {
                    const float dec = RET ? rdec : dall[m * 128 + 32 * t + crow(i, hh)];
                    S[t][i] = S[t][i] * dec + U[(size_t)it2 * USZ + (t * 16 + i) * 256 + tid];
                }
        }
    }
    const int d = tid % DK, part = tid / DK;
    const float lbv = RET ? 0.f : ((const float*)(p.ws + OFF_LB))[l * 512 + h * 128 + d];
    float btot_run = 0.f;
    const int vdv = tid & 127, vhalf = tid >> 7;
    unsigned rq[TP], rz[TP], rv[16];
    auto prefetch = [&](int ch) {
        const int t0 = tok0 + ch * 32;
#pragma unroll
        for (int t = 0; t < TP; ++t) {
            const bf16_t* row = P + (size_t)(t0 + part * TP + t) * PC;
            if (OUT) rq[t] = row[qcol + d];
            rz[t] = row[kcol + d];
        }
#pragma unroll
        for (int t = 0; t < 16; ++t) rv[t] = P[(size_t)(t0 + vhalf * 16 + t) * PC + vcol + vdv];
    };
    prefetch(0);
#pragma unroll 1
    for (int ch = 0; ch < 16; ++ch) {
        const int t0 = tok0 + ch * 32;
        float run = 0.f;
        float lfv[TP], kvs[TP];
#pragma unroll
        for (int t = 0; t < TP; ++t) {
            const float z = __uint_as_float(rz[t] << 16);
            if (RET) { kvs[t] = z; lfv[t] = lgam; }
            else {
                const float sg = __builtin_amdgcn_rcpf(1.f + __builtin_amdgcn_exp2f(-1.4426950408889634f * z));
                lfv[t] = __logf(fmaxf(lbv + (1.f - lbv) * sg, 1e-20f));
                kvs[t] = (1.f - lbv) * (1.f - sg);
            }
            run += lfv[t];
        }
        tots[part * DK + d] = run;
        *(u32x4*)(VTs + vdv * PT + vhalf * 16) = (u32x4){rv[0] | (rv[1] << 16), rv[2] | (rv[3] << 16), rv[4] | (rv[5] << 16), rv[6] | (rv[7] << 16)};
        *(u32x4*)(VTs + vdv * PT + vhalf * 16 + 8) = (u32x4){rv[8] | (rv[9] << 16), rv[10] | (rv[11] << 16), rv[12] | (rv[13] << 16), rv[14] | (rv[15] << 16)};
        __syncthreads();
        float base = 0.f, rref = 0.f, blast = 0.f;
#pragma unroll
        for (int pp = 0; pp < NP; ++pp) { const float tt = tots[pp * DK + d]; if (pp < part) base += tt; if (pp < NP / 2) rref += tt; blast += tt; }
        unsigned khp[TP / 2];
        float bt = base;
        const float er = __expf(rref), ebr = __expf(blast - rref);
#pragma unroll
        for (int t = 0; t < TP; ++t) {
            const float kvv = kvs[t];
            bt += lfv[t];
            const int tr = part * TP + t;
            unsigned khb;
            if (OUT) {
                const float qv = __uint_as_float(rq[t] << 16);
                const float e1 = __expf(bt - rref), e2 = __builtin_amdgcn_rcpf(e1);
                Qt[tr * PQ + d] = f2bf(qv * e1);
                Qh[tr * PQ + d] = f2bf(qv * e1 * er);
                Kt[tr * PQ + d] = f2bf(kvv * e2);
                khb = f2bf(kvv * e2 * ebr);
            } else {
                khb = f2bf(kvv * __expf(blast - bt));
            }
            if (t & 1) khp[t >> 1] |= khb << 16; else khp[t >> 1] = khb;
        }
        *(u32x4*)(KhT + d * PT + part * TP) = (u32x4){khp[0], khp[1], khp[2], khp[3]};
        if (TP == 16) *(u32x4*)(KhT + d * PT + part * TP + 8) = (u32x4){khp[TP / 2 - 4], khp[TP / 2 - 3], khp[TP / 2 - 2], khp[TP / 2 - 1]};
        if (part == 0) { decs[d] = __expf(blast); btot_run += blast; }
        if (ch + 1 < 16) prefetch(ch + 1);
        __syncthreads();
        f32x16 o;
        u32x2 gate_r[4];
        if (OUT) {
#pragma unroll
            for (int g = 0; g < 4; ++g) gate_r[g] = *(const u32x2*)(P + (size_t)(t0 + ql) * PC + gcol + 32 * wave + 8 * g + 4 * hh);
        }
        if (OUT) {
            f32x16 at;
#pragma unroll
            for (int i = 0; i < 16; ++i) { at[i] = 0.f; o[i] = 0.f; }
#pragma unroll
            for (int ks = 0; ks < DK / 16; ++ks) {
                const bf16x8 kf = *(const bf16x8*)(Kt + ql * PQ + 16 * ks + 8 * hh);
                const bf16x8 qf = *(const bf16x8*)(Qt + ql * PQ + 16 * ks + 8 * hh);
                at = mfma32(kf, qf, at);
            }
#pragma unroll
            for (int i = 0; i < 16; ++i) if (crow(i, hh) > ql) at[i] = 0.f;
#pragma unroll
            for (int s2 = 0; s2 < 2; ++s2) {
                const bf16x8 pa = pack8(at[8 * s2], at[8 * s2 + 1], at[8 * s2 + 2], at[8 * s2 + 3], at[8 * s2 + 4], at[8 * s2 + 5], at[8 * s2 + 6], at[8 * s2 + 7]);
                const bf16_t* vp = VTs + (32 * wave + ql) * PT + 16 * s2 + 4 * hh;
                o = mfma32(join8(*(const u32x2*)vp, *(const u32x2*)(vp + 8)), pa, o);
            }
#pragma unroll
            for (int t = 0; t < NT; ++t)
#pragma unroll
                for (int s2 = 0; s2 < 2; ++s2) {
                    const bf16x8 sf = pack8(S[t][8 * s2], S[t][8 * s2 + 1], S[t][8 * s2 + 2], S[t][8 * s2 + 3], S[t][8 * s2 + 4], S[t][8 * s2 + 5], S[t][8 * s2 + 6], S[t][8 * s2 + 7]);
                    const bf16_t* qp = Qh + ql * PQ + 32 * t + 16 * s2 + 4 * hh;
                    o = mfma32(sf, join8(*(const u32x2*)qp, *(const u32x2*)(qp + 8)), o);
                }
        }
#pragma unroll
        for (int t = 0; t < NT; ++t) {
#pragma unroll
            for (int i = 0; i < 16; ++i) S[t][i] *= decs[32 * t + crow(i, hh)];
#pragma unroll
            for (int s2 = 0; s2 < 2; ++s2) {
                const bf16x8 kf = *(const bf16x8*)(KhT + (32 * t + ql) * PT + 16 * s2 + 8 * hh);
                const bf16x8 vf = *(const bf16x8*)(VTs + (32 * wave + ql) * PT + 16 * s2 + 8 * hh);
                S[t] = mfma32(kf, vf, S[t]);
            }
        }
        if (OUT) {
            float ss = 0.f;
#pragma unroll
            for (int i = 0; i < 16; ++i) ss += o[i] * o[i];
            ss += __shfl_xor(ss, 32);
            if (hh == 0) sums[wave * 32 + ql] = ss;
            __syncthreads();
            const float tot = sums[ql] + sums[32 + ql] + sums[64 + ql] + sums[96 + ql];
            const float rstd = rsqrtf(tot * (1.f / 128.f) + EPSF);
            bf16_t* gp = P + (size_t)(t0 + ql) * PC + gcol;
#pragma unroll
            for (int g = 0; g < 4; ++g) {
                const int dv = 32 * wave + 8 * g + 4 * hh;
                const f32x4 gate = unpk4(gate_r[g]);
                f32x4 y;
#pragma unroll
                for (int jj = 0; jj < 4; ++jj) { const float gn = RET ? 1.f : p.hg_onorm[l * 128 + dv + jj]; y[jj] = o[4 * g + jj] * rstd * gn * gate[jj]; }
                if (!dry) *(u32x2*)(gp + dv) = pk4(y);
            }
        } else {
            __syncthreads();
        }
    }
    if (!OUT) {
#pragma unroll
        for (int t = 0; t < NT; ++t)
#pragma unroll
            for (int i = 0; i < 16; ++i) U[(size_t)item * USZ + (t * 16 + i) * 256 + tid] = S[t][i];
        if (!RET && part == 0) HB[item * 128 + d] = btot_run;
    }
    __syncthreads();
}

DI void merge_item(const Params& p, int mt, int nt, unsigned char* smb) {
    const int m0 = mt * 256, n0 = nt * 128;
    f32x4 am[4][4]; zero_acc<4, 4>(am);
    const bf16_t* H = (const bf16_t*)(p.ws + OFF_H) + (size_t)m0 * 1024;
    bf16_t* P = (bf16_t*)(p.ws + OFF_P);
#pragma unroll 1
    for (int br = 0; br < 3; ++br) {
        const int ycol = br == 0 ? C_HG : (br == 1 ? C_GB : C_RG);
        u32x2 sg[4][4];
        { f32x4 ag[4][4]; zero_acc<4, 4>(ag);
          gemm8<4, 4, 2>(H, 1024, (const bf16_t*)(p.ws + OFF_WM) + (size_t)(br * 1024 + n0) * 1024, 1024, 1024, ag, smb);
#pragma unroll
          for (int i = 0; i < 4; ++i)
#pragma unroll
              for (int j = 0; j < 4; ++j) { f32x4 g;
#pragma unroll
                  for (int jj = 0; jj < 4; ++jj) g[jj] = sigmoidf_(ag[i][j][jj]);
                  sg[i][j] = pk4(g); } }
        f32x4 ay[4][4]; zero_acc<4, 4>(ay);
        gemm8<4, 4, 2>(P + (size_t)m0 * PC + ycol, PC, (const bf16_t*)(p.ws + OFF_WP) + (size_t)br * 1024 * 512 + (size_t)n0 * 512, 512, 512, ay, smb);
#pragma unroll
        for (int i = 0; i < 4; ++i)
#pragma unroll
            for (int j = 0; j < 4; ++j) { const f32x4 g = unpk4(sg[i][j]);
#pragma unroll
                for (int jj = 0; jj < 4; ++jj) am[i][j][jj] += g[jj] * ay[i][j][jj]; }
    }
    const int tid = tid8_(), lane = tid & 63, wave = tid >> 6, wm = wave >> 1, wn = wave & 1, fr = lane & 15, fq = lane >> 4;
#pragma unroll
    for (int i = 0; i < 4; ++i) {
        const int row = m0 + 64 * wm + 16 * i + fr;
#pragma unroll
        for (int g = 0; g < 2; ++g) { const u32x2 lo = pk4(am[i][2 * g]), hi = pk4(am[i][2 * g + 1]);
            *(u32x4*)(P + (size_t)row * PC + n0 + 64 * wn + 32 * g + 8 * fq) = (u32x4){lo.x, lo.y, hi.x, hi.y}; }
    }
}

DI void out_item(const Params& p, int l, int mt, int nt, unsigned char* smb, int dry) {
    const int m0 = mt * 256, n0 = nt * 256;
    f32x4 acc[8][4]; zero_acc<8, 4>(acc);
    gemm8<8, 4, 4>((const bf16_t*)(p.ws + OFF_P) + (size_t)m0 * PC, PC, (const bf16_t*)(p.ws + OFF_WOUT) + (size_t)n0 * 1024, 1024, 1024, acc, smb);
    const int tid = tid8_(), lane = tid & 63, wave = tid >> 6, wm = wave >> 2, wn = wave & 3, fr = lane & 15, fq = lane >> 4;
    const float* xin = l == 0 ? p.x : p.out;
#pragma unroll
    for (int i = 0; i < 8; ++i) {
        const int row = m0 + 128 * wm + 16 * i + fr, b = row >> 13;
        const float* gate = (const float*)(p.ws + OFF_MOD) + (l * 2 + b) * 3072 + 2048;
#pragma unroll
        for (int j = 0; j < 4; ++j) {
            const int col = n0 + 64 * wn + 16 * j + 4 * fq;
            const f32x4 xo = *(const f32x4*)(xin + (size_t)row * 1024 + col), g = *(const f32x4*)(gate + col);
            f32x4 r;
#pragma unroll
            for (int jj = 0; jj < 4; ++jj) r[jj] = xo[jj] + g[jj] * acc[i][j][jj];
            if (!dry) *(f32x4*)(p.out + (size_t)row * 1024 + col) = r;
        }
    }
}

constexpr int LDS_BYTES = 131072, HALF_LDS = 65536;
constexpr int N_PHASES = 14;
DI void phase_prep(const Params& p, unsigned char* sm) {
    const int bid = blockIdx.x, G = gridDim.x, vb = vb_();
    unsigned char* smv = sm + vb * HALF_LDS;
    if (bid == 0) { const int t = tid8_(); if (t < 256) ((unsigned*)p.ws)[t] = 0u; }
    if (bid == G - 1 && vb == 1) lb_item(p);
#pragma unroll 1
    for (int k = bid; k < 96; k += G) mod_item(p, 2 * k + vb, (float*)smv);
}
DI void phase_final(const Params& p) { for (int it = 2 * blockIdx.x + vb_(); it < 4096; it += 2 * gridDim.x) final_item(p, it); }
template <int SP> DI void layer_phase(const Params& p, int l, unsigned char* sm, int dry, int qidx) {
    const int bid = blockIdx.x, G = gridDim.x, vb = vb_();
    unsigned char* smv = sm + vb * HALF_LDS;
    if (SP == 0) {
#pragma unroll 1
        for (int it = 2 * bid + vb; it < 4096; it += 2 * G) norm_item(p, l, it);
#pragma unroll 1
        for (int k = G - 1 - bid; k < CONV_ITEMS / 2; k += G) conv_weights(p, l, 2 * k + vb, (float*)smv);
    } else if (SP == 1) {
#pragma unroll 1
        for (int q = bid >> 3; q < 8 * INPROJ_NT; q += (G >> 3)) inproj_item(p, 8 * (bid & 7) + (q & 7), q >> 3, sm, dry);
    } else if (SP == 2) {
        const int xcd = bid & 7, nq = G >> 3;
        unsigned* ctr = (unsigned*)p.ws + qidx + xcd * 2;
        int it = bid >> 3;
#pragma unroll 1
        for (;;) {
            if (it >= 88) break;
            if (it < 8) { for (int r = 0; r < REPG2; ++r) gla_item<128, false, false>(p, l, 2 * (xcd * 8 + it) + vb, smv, dry); }
            else if (it < 16) { for (int r = 0; r < REPG2; ++r) gla_item<64, true, false>(p, l, 2 * (xcd * 8 + it - 8) + vb, smv, dry); }
            else if (it < 24) kr_item(p, xcd * 8 + it - 16);
            else if (it < 56) { for (int r = 0; r < REPQ2; ++r) qup_item(p, xcd * 32 + it - 24, (bf16_t*)sm, dry | (r + 1 < REPQ2)); }
            else { const int t = xcd * 32 + it - 56; for (int r = 0; r < REPK2; ++r) kvup_item(p, t >> 2, t & 3, sm); }
            it = nq + grab_item(ctr, sm);
        }
    } else if (SP == 3) {
        const int xcd = bid & 7;
        unsigned* ctr = (unsigned*)p.ws + qidx + xcd * 2;
        int it = bid >> 3;
#pragma unroll 1
        for (;; it = (G >> 3) + grab_item(ctr, sm)) {
            if (it >= 80) break;
            if (it < 8) { for (int r = 0; r < REPG3; ++r) gla_item<128, false, true>(p, l, 2 * (xcd * 8 + it) + vb, smv, dry | (r + 1 < REPG3)); }
            else if (it < 16) { for (int r = 0; r < REPG3; ++r) gla_item<64, true, true>(p, l, 2 * (xcd * 8 + it - 8) + vb, smv, dry | (r + 1 < REPG3)); }
            else { for (int r = 0; r < REPA3; ++r) attn_item(p, 31 - ((it - 16) >> 1), 2 * xcd + ((it - 16) & 1), (bf16_t*)sm, dry | (r + 1 < REPA3)); }
        }
    } else if (SP == 4) {
#pragma unroll 1
        for (int q = bid >> 3; q < 8 * 8; q += (G >> 3)) merge_item(p, 8 * (bid & 7) + (q & 7), q >> 3, sm);
    } else {
#pragma unroll 1
        for (int q = bid >> 3; q < 8 * 4; q += (G >> 3)) out_item(p, l, 8 * (bid & 7) + (q & 7), q >> 3, sm, dry);
    }
}

#if ONE_LAUNCH
__global__ void __launch_bounds__(512, 2) __attribute__((amdgpu_waves_per_eu(2, 2))) fwd_megakernel(Params p) {
    extern __shared__ __attribute__((aligned(1024))) unsigned char sm[];
    cg::grid_group grid = cg::this_grid();
    unsigned* gbar = (unsigned*)(p.ws + OFF_BAR); unsigned gk = 0;
    phase_prep(p, sm); grid.sync();
#define RUN_PH(SP, L, REP) for (int rep = 0; rep < (REP); ++rep) { int dry = (rep + 1 < (REP)) ? 1 : 0; asm volatile("" : "+s"(dry)); layer_phase<SP>(p, L, sm, dry, (L) * 128 + (SP) * 16 + rep); grid_barrier(gbar, ++gk); }
    RUN_PH(0, 0, REP0) RUN_PH(1, 0, REP1) RUN_PH(2, 0, REP2) RUN_PH(3, 0, REP3) RUN_PH(4, 0, REP4) RUN_PH(5, 0, REP5)
    RUN_PH(0, 1, REP0) RUN_PH(1, 1, REP1) RUN_PH(2, 1, REP2) RUN_PH(3, 1, REP3) RUN_PH(4, 1, REP4) RUN_PH(5, 1, REP5)
    phase_final(p);
}
#else
__global__ void __launch_bounds__(512, 2) phase_kernel(Params p, int ph) {
    extern __shared__ __attribute__((aligned(1024))) unsigned char sm[];
    if (ph == 0) { phase_prep(p, sm); return; }
    if (ph == 13) { phase_final(p); return; }
    const int l = (ph - 1) / 6, sp = (ph - 1) % 6;
    if (sp == 0) layer_phase<0>(p, l, sm, 0, l * 128 + 0 * 16); else if (sp == 1) layer_phase<1>(p, l, sm, 0, l * 128 + 1 * 16); else if (sp == 2) layer_phase<2>(p, l, sm, 0, l * 128 + 2 * 16);
    else if (sp == 3) layer_phase<3>(p, l, sm, 0, l * 128 + 3 * 16); else if (sp == 4) layer_phase<4>(p, l, sm, 0, l * 128 + 4 * 16); else layer_phase<5>(p, l, sm, 0, l * 128 + 5 * 16);
}
#endif

extern "C" void kernel_launch(void* const* d_in, const int* in_sizes, int n_in, void* d_out, int out_size, void* d_ws, size_t ws_size, hipStream_t stream) {
    Params p{};
    p.x = (const float*)d_in[0]; p.c = (const float*)d_in[1]; p.pos = (const int*)d_in[2]; p.norm_g = (const float*)d_in[3];
    p.w_mod = (const float*)d_in[4]; p.b_mod = (const float*)d_in[5]; p.w_in = (const float*)d_in[6]; p.hg_lb = (const float*)d_in[7];
    p.hg_onorm = (const float*)d_in[8]; p.g_cq = (const float*)d_in[9]; p.w_uq = (const float*)d_in[10]; p.g_ckv = (const float*)d_in[11];
    p.w_ukv = (const float*)d_in[12]; p.w_pa = (const float*)d_in[13]; p.w_pb = (const float*)d_in[14]; p.w_pc = (const float*)d_in[15];
    p.w_out = (const float*)d_in[16]; p.final_g = (const float*)d_in[17];
    p.out = (float*)d_out; p.ws = (unsigned char*)d_ws;
#if ONE_LAUNCH
    static int grid_blocks = 0;
    if (!grid_blocks) {
        int dev = 0, cus = 0, per_cu = 0;
        (void)hipGetDevice(&dev);
        (void)hipDeviceGetAttribute(&cus, hipDeviceAttributeMultiprocessorCount, dev);
        if (hipFuncSetAttribute((const void*)fwd_megakernel, hipFuncAttributeMaxDynamicSharedMemorySize, LDS_BYTES) != hipSuccess)
            fprintf(stderr, "hipFuncSetAttribute(MaxDynamicSharedMemorySize=%d) failed\n", LDS_BYTES);
        (void)hipOccupancyMaxActiveBlocksPerMultiprocessor(&per_cu, fwd_megakernel, 512, LDS_BYTES);
        if (per_cu < 1) per_cu = 1;
        if (per_cu > 1) per_cu = 1;
        grid_blocks = (cus / 8) * 8 * per_cu;
    }
    (void)hipMemsetAsync((unsigned char*)d_ws + OFF_BAR, 0, BAR_BYTES, stream);
    void* args[] = {&p};
    hipError_t e = hipLaunchCooperativeKernel((void*)fwd_megakernel, dim3(grid_blocks), dim3(512), args, LDS_BYTES, stream);
    if (e != hipSuccess) fprintf(stderr, "cooperative launch failed: %s (grid %d)\n", hipGetErrorString(e), grid_blocks);
#else
    (void)hipFuncSetAttribute((const void*)phase_kernel, hipFuncAttributeMaxDynamicSharedMemorySize, LDS_BYTES);
    for (int ph = 0; ph < N_PHASES; ++ph) phase_kernel<<<256, 512, LDS_BYTES, stream>>>(p, ph);
#endif
}
```
